# Optimizing an MI355X kernel written in HIP

```python
import math
import jax, jax.numpy as jnp
from jax import lax
import numpy as np

D_MODEL = 2048
BATCH = 4
SEQ = 2048
DEPTH = 4

DA_HEADS = 4
DA_HD = 64
DA_W = DA_HEADS * 2 * DA_HD
SW_HEADS = 8
SW_KV = 2
SW_HD = 64
WINDOW = 128
SW_QW = SW_HEADS * SW_HD
SW_KW = SW_KV * SW_HD
MB_HEADS = 8
MB_HD = 64
MB_W = MB_HEADS * MB_HD
MB_BLOCK = 256
MB_TOPK = 3
MB_CHUNK = 32
Q_BLOCK = 128
N_BUCKETS = 32
MAX_DIST = 128
N_ATT_HEADS = DA_HEADS + SW_HEADS + MB_HEADS
N_BRANCH = 3
IN_W = 3 * DA_W + SW_QW + 2 * SW_KW + 3 * MB_W + N_BRANCH * D_MODEL
D_FF = 5632
CONV_W = 3
EPS = 1e-6

kernel_name = "hybrid_gated_diff_swa_moba_convffn"


def rmsnorm(x, g):
    xf = x.astype(jnp.float32)
    y = xf * lax.rsqrt(jnp.mean(xf * xf, axis=-1, keepdims=True) + EPS)
    return (y * g.astype(jnp.float32)).astype(x.dtype)


def rel_bucket(dist):
    n = jnp.maximum(dist, 0)
    max_exact = N_BUCKETS // 2
    nf = jnp.maximum(n, 1).astype(jnp.float32)
    large = max_exact + (jnp.log(nf / max_exact) / math.log(MAX_DIST / max_exact)
                         * (N_BUCKETS - max_exact)).astype(jnp.int32)
    large = jnp.minimum(large, N_BUCKETS - 1)
    return jnp.where(n < max_exact, n, large)


def diff_attention(q, k, v, lam, lam_init, subln_g, bias_t):
    B, S = q.shape[0], q.shape[1]
    nb = S // Q_BLOCK
    scale = DA_HD ** -0.5
    qb = jnp.moveaxis(q.reshape(B, nb, Q_BLOCK, DA_HEADS, 2, DA_HD), 1, 0)
    kpos = jnp.arange(S)

    def block(args):
        qi, i = args
        qpos = i * Q_BLOCK + jnp.arange(Q_BLOCK)
        dist = qpos[:, None] - kpos[None, :]
        bias = jnp.take(bias_t, rel_bucket(dist), axis=1)
        logits = jnp.einsum('bqhmd,bkhmd->bhmqk', qi, k).astype(jnp.float32) * scale + bias[None, :, None]
        logits = jnp.where(dist >= 0, logits, -jnp.inf)
        p = jax.nn.softmax(logits, axis=-1)
        attn = p[:, :, 0] - lam * p[:, :, 1]
        return jnp.einsum('bhqk,bkhe->bqhe', attn.astype(v.dtype), v)

    o = lax.map(block, (qb, jnp.arange(nb)))
    o = jnp.moveaxis(o, 0, 1).reshape(B, S, DA_HEADS, 2 * DA_HD)
    o = rmsnorm(o, subln_g) * (1.0 - lam_init)
    return o.reshape(B, S, DA_W)


def sliding_window_attention(q, k, v, sinks, bias_t):
    B, S = q.shape[0], q.shape[1]
    nb = S // Q_BLOCK
    G = SW_HEADS // SW_KV
    scale = SW_HD ** -0.5
    qb = q.reshape(B, nb, Q_BLOCK, SW_KV, G, SW_HD)
    kb = k.reshape(B, nb, Q_BLOCK, SW_KV, SW_HD)
    vb = v.reshape(B, nb, Q_BLOCK, SW_KV, SW_HD)
    shift = lambda t: jnp.concatenate([jnp.zeros_like(t[:, :1]), t[:, :-1]], axis=1)
    kc = jnp.concatenate([shift(kb), kb], axis=2)
    vc = jnp.concatenate([shift(vb), vb], axis=2)
    blk = jnp.arange(nb)[:, None] * Q_BLOCK
    qpos = blk + jnp.arange(Q_BLOCK)[None]
    kpos = blk - Q_BLOCK + jnp.arange(2 * Q_BLOCK)[None]
    dist = qpos[:, :, None] - kpos[:, None, :]
    valid = (dist >= 0) & (dist < WINDOW) & (kpos[:, None, :] >= 0)
    bias = jnp.take(bias_t, rel_bucket(dist), axis=1)
    bias = jnp.moveaxis(bias.reshape(SW_KV, G, nb, Q_BLOCK, 2 * Q_BLOCK), 2, 0)
    logits = jnp.einsum('bnqkgd,bnskd->bnkgqs', qb, kc).astype(jnp.float32) * scale + bias[None]
    logits = jnp.where(valid[None, :, None, None], logits, -jnp.inf)
    sink = jnp.broadcast_to(sinks.astype(jnp.float32).reshape(1, 1, SW_KV, G, 1, 1),
                            logits.shape[:-1] + (1,))
    p = jax.nn.softmax(jnp.concatenate([logits, sink], axis=-1), axis=-1)[..., :-1]
    o = jnp.einsum('bnkgqs,bnskd->bnqkgd', p.astype(vc.dtype), vc)
    return o.reshape(B, S, SW_QW)


def moba_attention(q, k, v, bias_t):
    B, S = q.shape[0], q.shape[1]
    nblk = -(-S // MB_BLOCK)
    Sp = nblk * MB_BLOCK
    padw = ((0, 0), (0, Sp - S), (0, 0), (0, 0))
    q, k, v = [jnp.pad(t, padw).transpose(0, 2, 1, 3) for t in (q, k, v)]
    scale = MB_HD ** -0.5
    kblk = k.reshape(B, MB_HEADS, nblk, MB_BLOCK, MB_HD)
    vblk = v.reshape(B, MB_HEADS, nblk, MB_BLOCK, MB_HD)
    kmean = jnp.mean(kblk.astype(jnp.float32), axis=3)
    own = jnp.arange(Sp) // MB_BLOCK
    gate = jnp.einsum('bhtd,bhnd->bhtn', q.astype(jnp.float32), kmean)
    past = jnp.arange(nblk)[None, :] < own[:, None]
    gate = jnp.where(past, gate, -jnp.inf)
    topk = min(MB_TOPK, nblk)
    _, idx = lax.top_k(gate, topk)

    nch = Sp // MB_CHUNK
    per_blk = MB_BLOCK // MB_CHUNK
    qc = q.reshape(B, MB_HEADS, nch, MB_CHUNK, MB_HD).transpose(2, 0, 1, 3, 4)
    idxc = idx.reshape(B, MB_HEADS, nch, MB_CHUNK, topk).transpose(2, 0, 1, 3, 4)
    bi = jnp.arange(B)[:, None, None, None]
    hi = jnp.arange(MB_HEADS)[None, :, None, None]
    hi5 = hi[..., None]
    s_off = jnp.arange(MB_BLOCK)

    def chunk(args):
        qi, ii, c = args
        qpos = c * MB_CHUNK + jnp.arange(MB_CHUNK)
        ob = c // per_blk
        ks = kblk[bi, hi, ii]
        vs = vblk[bi, hi, ii]
        dist_s = qpos[None, None, :, None, None] - (ii[..., None] * MB_BLOCK + s_off)
        ls = (jnp.einsum('bhcd,bhcjsd->bhcjs', qi, ks).astype(jnp.float32) * scale
              + bias_t[hi5, rel_bucket(dist_s)])
        ls = jnp.where((jnp.arange(topk) < ob)[:, None], ls, -jnp.inf)
        ls = ls.reshape(B, MB_HEADS, MB_CHUNK, topk * MB_BLOCK)
        ko = lax.dynamic_slice_in_dim(k, ob * MB_BLOCK, MB_BLOCK, axis=2)
        vo = lax.dynamic_slice_in_dim(v, ob * MB_BLOCK, MB_BLOCK, axis=2)
        dist_o = qpos[:, None] - (ob * MB_BLOCK + s_off)[None, :]
        lo = (jnp.einsum('bhcd,bhsd->bhcs', qi, ko).astype(jnp.float32) * scale
              + jnp.take(bias_t, rel_bucket(dist_o), axis=1)[None])
        lo = jnp.where(dist_o >= 0, lo, -jnp.inf)
        p = jax.nn.softmax(jnp.concatenate([ls, lo], axis=-1), axis=-1).astype(vs.dtype)
        ps = p[..., :topk * MB_BLOCK].reshape(B, MB_HEADS, MB_CHUNK, topk, MB_BLOCK)
        po = p[..., topk * MB_BLOCK:]
        return (jnp.einsum('bhcjs,bhcjsd->bhcd', ps, vs)
                + jnp.einsum('bhcs,bhsd->bhcd', po, vo))

    o = lax.map(chunk, (qc, idxc, jnp.arange(nch)))
    o = o.transpose(1, 0, 3, 2, 4).reshape(B, Sp, MB_W)
    return o[:, :S]


def conv_ffn(h, w_up, conv_w, conv_b, w_down):
    S = h.shape[1]
    u = h @ w_up
    up = jnp.pad(u, ((0, 0), (CONV_W - 1, 0), (0, 0)))
    c = conv_b
    for i in range(CONV_W):
        c = c + up[:, i:i + S] * conv_w[i]
    gate, val = jnp.split(c, 2, axis=-1)
    return (jax.nn.gelu(gate, approximate=True) * val) @ w_down


def setup_inputs(seed: int = 0) -> dict:
    key = jax.random.key(seed)
    ks = jax.random.split(key, 24)
    f32 = jnp.float32
    nrm = lambda k, shape, s: jax.random.normal(k, shape, f32) * s
    gain = lambda k: 1.0 + nrm(k, (DEPTH, D_MODEL), 0.02)
    return {
        "x": nrm(ks[0], (BATCH, SEQ, D_MODEL), 1.0),
        "rel_bias_table": nrm(ks[1], (N_BUCKETS, N_ATT_HEADS), 0.5),
        "w_in": nrm(ks[2], (DEPTH, D_MODEL, IN_W), D_MODEL ** -0.5),
        "b_gate": nrm(ks[3], (DEPTH, N_BRANCH * D_MODEL), 0.1),
        "lam_q1": nrm(ks[4], (DEPTH, DA_HD), 0.1),
        "lam_k1": nrm(ks[5], (DEPTH, DA_HD), 0.1),
        "lam_q2": nrm(ks[6], (DEPTH, DA_HD), 0.1),
        "lam_k2": nrm(ks[7], (DEPTH, DA_HD), 0.1),
        "diff_subln_g": 1.0 + nrm(ks[8], (DEPTH, 2 * DA_HD), 0.02),
        "sinks": nrm(ks[9], (DEPTH, SW_HEADS), 0.5),
        "w_oa": nrm(ks[10], (DEPTH, DA_W, D_MODEL), DA_W ** -0.5),
        "w_ob": nrm(ks[11], (DEPTH, SW_QW, D_MODEL), SW_QW ** -0.5),
        "w_oc": nrm(ks[12], (DEPTH, MB_W, D_MODEL), MB_W ** -0.5),
        "w_out": nrm(ks[13], (DEPTH, D_MODEL, D_MODEL), D_MODEL ** -0.5),
        "pre_mix_g": gain(ks[14]),
        "post_mix_g": gain(ks[15]),
        "pre_ffn_g": gain(ks[16]),
        "post_ffn_g": gain(ks[17]),
        "w_up": nrm(ks[18], (DEPTH, D_MODEL, 2 * D_FF), D_MODEL ** -0.5),
        "conv_w": nrm(ks[19], (DEPTH, CONV_W, 2 * D_FF), CONV_W ** -0.5),
        "conv_b": nrm(ks[20], (DEPTH, 2 * D_FF), 0.02),
        "w_down": nrm(ks[21], (DEPTH, D_FF, D_MODEL), D_FF ** -0.5),
    }


def reference(x, rel_bias_table, w_in, b_gate, lam_q1, lam_k1, lam_q2, lam_k2, diff_subln_g,
              sinks, w_oa, w_ob, w_oc, w_out, pre_mix_g, post_mix_g, pre_ffn_g, post_ffn_g,
              w_up, conv_w, conv_b, w_down):
    B, S = x.shape[0], x.shape[1]
    tab_t = rel_bias_table.T
    tab_a = tab_t[:DA_HEADS]
    tab_b = tab_t[DA_HEADS:DA_HEADS + SW_HEADS]
    tab_c = tab_t[DA_HEADS + SW_HEADS:]
    cuts = list(np.cumsum([DA_W, DA_W, DA_W, SW_QW, SW_KW, SW_KW, MB_W, MB_W, MB_W]))
    for l in range(DEPTH):
        h = rmsnorm(x, pre_mix_g[l])
        proj = h @ w_in[l]
        qa, ka, va, qb, kb, vb, qc, kc, vc, g = jnp.split(proj, cuts, axis=-1)
        gates = jax.nn.sigmoid((g + b_gate[l]).astype(jnp.float32)).astype(x.dtype)
        ga, gb, gc = jnp.split(gates, N_BRANCH, axis=-1)

        lam_init = 0.8 - 0.6 * math.exp(-0.3 * l)
        lam = (jnp.exp(jnp.sum(lam_q1[l].astype(jnp.float32) * lam_k1[l].astype(jnp.float32)))
               - jnp.exp(jnp.sum(lam_q2[l].astype(jnp.float32) * lam_k2[l].astype(jnp.float32)))
               + lam_init)
        ya = diff_attention(qa.reshape(B, S, DA_HEADS, 2, DA_HD), ka.reshape(B, S, DA_HEADS, 2, DA_HD),
                            va.reshape(B, S, DA_HEADS, 2 * DA_HD), lam, lam_init, diff_subln_g[l], tab_a)
        yb = sliding_window_attention(qb.reshape(B, S, SW_HEADS, SW_HD), kb.reshape(B, S, SW_KV, SW_HD),
                                      vb.reshape(B, S, SW_KV, SW_HD), sinks[l], tab_b)
        yc = moba_attention(qc.reshape(B, S, MB_HEADS, MB_HD), kc.reshape(B, S, MB_HEADS, MB_HD),
                            vc.reshape(B, S, MB_HEADS, MB_HD), tab_c)
        mix = ga * (ya @ w_oa[l]) + gb * (yb @ w_ob[l]) + gc * (yc @ w_oc[l])
        x = x + rmsnorm(mix @ w_out[l], post_mix_g[l])
        h = rmsnorm(x, pre_ffn_g[l])
        x = x + rmsnorm(conv_ffn(h, w_up[l], conv_w[l], conv_b[l], w_down[l]), post_ffn_g[l])
    return x
```

```cpp
#include <hip/hip_runtime.h>
#include <hip/hip_cooperative_groups.h>
#include <cstdio>
#include <cstdint>
namespace cg = cooperative_groups;

#ifndef PH_MASK
#define PH_MASK 511
#endif
#ifndef ATTN_INL
#define ATTN_INL __device__ __forceinline__
#endif
#ifndef KIND_MASK
#define KIND_MASK 7
#endif
#ifndef USE_XCD_BAR
#define USE_XCD_BAR 1
#endif
#ifndef DUP_KIND
#define DUP_KIND 7
#endif
#ifndef N_LAUNCH_MODE
#define N_LAUNCH_MODE 1
#endif

#define DI __device__ __forceinline__
#define LAS __attribute__((address_space(3)))
typedef unsigned short bf16_t;
typedef short bf16x8 __attribute__((ext_vector_type(8)));
typedef short s16x4 __attribute__((ext_vector_type(4)));
typedef float f32x4 __attribute__((ext_vector_type(4)));
typedef float f32x2 __attribute__((ext_vector_type(2)));
typedef float f32x16 __attribute__((ext_vector_type(16)));
typedef unsigned u32x4 __attribute__((ext_vector_type(4)));
typedef unsigned u32x2 __attribute__((ext_vector_type(2)));
typedef __bf16 bf16x2n __attribute__((ext_vector_type(2)));

constexpr int DM = 2048, NB = 4, SEQ = 2048, DEPTH = 4, M = NB * SEQ;
constexpr int INW = 9984, DFF = 5632, UPW = 11264, YW = 1536;
constexpr int C_QA = 0, C_KA = 512, C_VA = 1024, C_QB = 1536, C_KB = 2048, C_VB = 2176, C_QC = 2304, C_KC = 2816, C_VC = 3328, C_G = 3840;
constexpr float EPS = 1e-6f;
constexpr float LOG2E = 1.4426950408889634f;
constexpr float SC2 = 0.125f * LOG2E;
constexpr int TABN = 132;

constexpr size_t MiB = 1u << 20;
constexpr size_t WS_CTL = 0, CTL_ZERO_BYTES = 1 * MiB;
constexpr size_t WS_TAB = 1 * MiB;
constexpr size_t WS_WIN = 2 * MiB, WS_WO3 = 158 * MiB, WS_WOUT = 182 * MiB, WS_WUP = 214 * MiB, WS_WDN = 390 * MiB;
constexpr size_t WS_XN = 478 * MiB, WS_P = 510 * MiB, WS_Y = 666 * MiB, WS_TMP = 690 * MiB, WS_MIX = 754 * MiB, WS_U = 786 * MiB, WS_ACT = 962 * MiB, WS_XB = 1050 * MiB, WS_END = 1054 * MiB;
constexpr int CW_SEAM = 16384;
constexpr int LDS_BYTES = 147456;

DI unsigned pk2(float lo, float hi) { f32x2 v = {lo, hi}; return __builtin_bit_cast(unsigned, __builtin_convertvector(v, bf16x2n)); }
DI float bflo(unsigned w) { return __uint_as_float(w << 16); }
DI float bfhi(unsigned w) { return __uint_as_float(w & 0xffff0000u); }
DI float wave_sum(float v) {
#pragma unroll
    for (int o = 1; o < 64; o <<= 1) v += __shfl_xor(v, o);
    return v;
}
DI float fexp2(float x) { return __builtin_amdgcn_exp2f(x); }
DI float frcp(float x) { return __builtin_amdgcn_rcpf(x); }

namespace pg8 {
constexpr int BM = 256, BK = 64, HALF = 128, HTB = HALF * BK * 2, STAGE_BYTES = 8 * HTB, NXCD = 8, WGM = 8;
DI int lds_byte(int r, int c) { const int st = (r >> 4) * 2 + (c >> 5), rr = r & 15, cc = c & 31, ob = rr * 64 + cc * 2; return st * 1024 + (ob ^ (((ob >> 9) & 1) << 5)); }
DI void stage_rc(int b, int& R, int& C) { const int st = b / 1024, sb = b % 1024, swz = sb ^ (((sb >> 9) & 1) << 5); R = (st >> 1) * 16 + swz / 64; C = (st & 1) * 32 + (swz % 64) / 2; }
DI int perm32(int rho) { const int n = rho >> 4, i = rho & 15; return 8 * (i >> 2) + 4 * n + (i & 3); }

struct Unit { int pm, pn, z, mh; };
struct Gemm { const bf16_t* A; const bf16_t* Bt; int lda, ldb, K; long zA, zB; };

DI void tile_of(int wgid, int nM, int nN, Unit& u) {
    const int nwg = nM * nN;
    { const int q = nwg / NXCD, r = nwg % NXCD, xcd = wgid % NXCD, off = wgid / NXCD; wgid = (xcd < r ? xcd * (q + 1) : r * (q + 1) + (xcd - r) * q) + off; }
    const int nig = WGM * nN, gid = wgid / nig, fm = gid * WGM, gsz = (nM - fm) < WGM ? (nM - fm) : WGM;
    u.pm = fm + ((wgid % nig) % gsz); u.pn = (wgid % nig) / gsz;
}
struct StaticOrder {
    int nM, nN, nwg, G, c, lim;
    DI void init(int M_, int N_, int G_, int c_, int lim_ = 1 << 30) { nM = M_ / BM; nN = N_ / BM; nwg = nM * nN; G = G_; c = c_; lim = lim_; }
    DI bool next(int i, Unit& u) const {
        const long L = (long)i * G + c; if (L >= nwg || i >= lim) return false;
        tile_of((int)L, nM, nN, u); u.z = 0; u.mh = -1; return true;
    }
};
struct BranchOrder {
    int nM, nN, nwg, G, c;
    DI void init(int M_, int N_, int G_, int c_) { nM = M_ / BM; nN = N_ / BM; nwg = nM * nN; G = G_; c = c_; }
    DI bool next(int i, Unit& u) const {
        const long L = (long)(i / 3) * G + c; if (L >= nwg) return false;
        tile_of((int)L, nM, nN, u); u.z = i % 3; u.mh = -1; return true;
    }
};

struct HalfTailOrder {
    int nM, nN, nwg, G, c;
    DI void init(int M_, int N_, int G_, int c_) { nM = M_ / BM; nN = N_ / BM; nwg = nM * nN; G = G_; c = c_; }
    DI bool next(int i, Unit& u) const {
        if (i != 0) return false;
        const int full = nwg / G, rem = G / 2;
        tile_of(full * G + (c % rem), nM, nN, u); u.z = 0; u.mh = c / rem; return true;
    }
};

typedef f32x4 Acc[2][2][4][2];

template <class Epi, class Sched, bool ALIGN_EPI, bool HALFM = false>
DI void gemm_phase(int tid, LAS unsigned char* lds, const Gemm g, const Sched& S, const Epi& E) {
    const int wid = __builtin_amdgcn_readfirstlane(tid >> 6), lane = tid & 63, wr = wid >> 2, wc = wid & 3, fr = lane & 15, fq = lane >> 4;
    const int K = g.K, nt = K / BK;
    unsigned voffA[2], voffB[2];
#pragma unroll
    for (int i = 0; i < 2; ++i) { int R, C; stage_rc(tid * 16 + i * 8192, R, C); const int Rb = Epi::PERM ? ((R & ~31) + perm32(R & 31)) : R;
        voffA[i] = (unsigned)(R * g.lda + C) * 2u; voffB[i] = (unsigned)(Rb * g.ldb + C) * 2u; }
    const size_t kstep = (size_t)(BK * 2);
    const size_t hA = (size_t)HALF * g.lda * 2, hB = (size_t)HALF * g.ldb * 2, tA = 2 * hA, tB = 2 * hB;
    const unsigned ldsw = (unsigned)wid * 1024u;
    const int aoff = lds_byte(wr * 64 + fr, fq * 8), boff = lds_byte(wc * 32 + fr, fq * 8);
#define PG8_SA(b, h) (((b) * 2 + (h)) * HTB)
#define PG8_SB(b, h) ((4 + (b) * 2 + (h)) * HTB)
#define PG8_STAGE(bufoff, gbase, voff) do { _Pragma("unroll") for (int _i = 0; _i < 2; ++_i) \
        __builtin_amdgcn_global_load_lds((const unsigned*)((const char*)(gbase) + (voff)[_i]), (LAS unsigned*)(lds + (bufoff) + ldsw + _i * 8192), 16, 0, 0); } while (0)
#define PG8_LDA(dst, b, h) do { _Pragma("unroll") for (int m = 0; m < 4; ++m) _Pragma("unroll") for (int k = 0; k < 2; ++k) dst[m][k] = *(const LAS bf16x8*)(lds + PG8_SA(b, h) + aoff + m * 2048 + k * 1024); } while (0)
#define PG8_LDB(dst, b, h) do { _Pragma("unroll") for (int n = 0; n < 2; ++n) _Pragma("unroll") for (int k = 0; k < 2; ++k) dst[n][k] = *(const LAS bf16x8*)(lds + PG8_SB(b, h) + boff + n * 2048 + k * 1024); } while (0)
#define PG8_MMA(ai, bj, At, Bt) do { __builtin_amdgcn_s_setprio(1); _Pragma("unroll") for (int m = 0; m < 4; ++m) _Pragma("unroll") for (int n = 0; n < 2; ++n) _Pragma("unroll") for (int k = 0; k < 2; ++k) \
        acc[ai][bj][m][n] = __builtin_amdgcn_mfma_f32_16x16x32_bf16(Bt[n][k], At[m][k], acc[ai][bj][m][n], 0, 0, 0); __builtin_amdgcn_s_setprio(0); } while (0)
#define PG8_WAIT_V(n) asm volatile("s_waitcnt vmcnt(" #n ")" ::: "memory")
#define PG8_WAIT_L(n) asm volatile("s_waitcnt lgkmcnt(" #n ")" ::: "memory")
#define PG8_BAR __builtin_amdgcn_s_barrier()
#define PG8_SCHED __builtin_amdgcn_sched_barrier(0)
    Unit cur, nxt; int ui = 0;
    if (!S.next(0, cur)) return;
    Acc acc;
#pragma unroll
    for (int a = 0; a < 2; ++a)
#pragma unroll
        for (int b = 0; b < 2; ++b)
#pragma unroll
            for (int m = 0; m < 4; ++m)
#pragma unroll
                for (int n = 0; n < 2; ++n) acc[a][b][m][n] = (f32x4){0.f, 0.f, 0.f, 0.f};
    bf16x8 At[4][2], B0[2][2], B1[2][2];
    const char* cA = (const char*)(g.A + (size_t)cur.z * g.zA) + (size_t)cur.pm * tA + (cur.mh > 0 ? hA : (size_t)0); const char* cB = (const char*)(g.Bt + (size_t)cur.z * g.zB) + (size_t)cur.pn * tB;
    const size_t cH = HALFM ? (size_t)0 : hA;
    PG8_STAGE(PG8_SB(0, 0), cB, voffB); PG8_STAGE(PG8_SB(0, 1), cB + hB, voffB); PG8_STAGE(PG8_SA(0, 0), cA, voffA); PG8_STAGE(PG8_SA(0, 1), cA + cH, voffA);
    if (wr == 1) PG8_BAR;
    PG8_WAIT_V(2); PG8_BAR;
    PG8_STAGE(PG8_SB(1, 0), cB + kstep, voffB); PG8_STAGE(PG8_SA(1, 0), cA + kstep, voffA); PG8_STAGE(PG8_SB(1, 1), cB + hB + kstep, voffB);
    PG8_WAIT_V(6); PG8_BAR;
    for (;;) {
        const bool has_next = S.next(ui + 1, nxt);
        const char* nA = has_next ? (const char*)(g.A + (size_t)nxt.z * g.zA) + (size_t)nxt.pm * tA + (nxt.mh > 0 ? hA : (size_t)0) : cA; const char* nB = has_next ? (const char*)(g.Bt + (size_t)nxt.z * g.zB) + (size_t)nxt.pn * tB : cB;
        const size_t nH = cH;
        for (int t = 0; t < nt; t += 2) {
            const bool last = (t == nt - 2);
            const char* a1 = cA + (size_t)(t + 1) * kstep;
            const char* a2 = last ? nA : cA + (size_t)(t + 2) * kstep; const char* b2 = last ? nB : cB + (size_t)(t + 2) * kstep;
            const char* a3 = a2 + kstep; const char* b3 = b2 + kstep;
            PG8_LDB(B0, 0, 0); PG8_LDB(B1, 0, 1); PG8_SCHED; PG8_LDA(At, 0, 0); PG8_STAGE(PG8_SA(1, 1), a1 + cH, voffA);
            PG8_WAIT_V(8); PG8_WAIT_L(0); PG8_BAR; PG8_MMA(0, 0, At, B0); PG8_MMA(0, 1, At, B1); PG8_BAR; PG8_SCHED;
            PG8_LDA(At, 0, 1); PG8_STAGE(PG8_SB(0, 0), b2, voffB); PG8_STAGE(PG8_SB(0, 1), b2 + hB, voffB); PG8_STAGE(PG8_SA(0, 0), a2, voffA);
            PG8_WAIT_V(8); PG8_WAIT_L(0); PG8_BAR; if constexpr (!HALFM) { PG8_MMA(1, 0, At, B0); PG8_MMA(1, 1, At, B1); } PG8_BAR; PG8_SCHED;
            PG8_LDB(B0, 1, 0); PG8_LDB(B1, 1, 1); PG8_SCHED; PG8_LDA(At, 1, 0); PG8_STAGE(PG8_SA(0, 1), a2 + (last ? nH : cH), voffA);
            PG8_WAIT_V(8); PG8_WAIT_L(0); PG8_BAR; PG8_MMA(0, 0, At, B0); PG8_MMA(0, 1, At, B1); PG8_BAR; PG8_SCHED;
            PG8_LDA(At, 1, 1); PG8_STAGE(PG8_SB(1, 0), b3, voffB); PG8_STAGE(PG8_SB(1, 1), b3 + hB, voffB); PG8_STAGE(PG8_SA(1, 0), a3, voffA);
            PG8_WAIT_V(8); PG8_WAIT_L(0); PG8_BAR; if constexpr (!HALFM) { PG8_MMA(1, 0, At, B0); PG8_MMA(1, 1, At, B1); } PG8_BAR; PG8_SCHED;
        }
        if constexpr (ALIGN_EPI) { if (wr == 0) PG8_BAR; }
        if constexpr (!Epi::AFTER_DRAIN) E(acc, cur, wr, wc, fr, fq);
        if (!has_next) break;
        if (!(Epi::KEEP_ACC && nxt.z != 0))
#pragma unroll
        for (int a = 0; a < 2; ++a)
#pragma unroll
            for (int b = 0; b < 2; ++b)
#pragma unroll
                for (int m = 0; m < 4; ++m)
#pragma unroll
                    for (int n = 0; n < 2; ++n) acc[a][b][m][n] = (f32x4){0.f, 0.f, 0.f, 0.f};
        cur = nxt; cA = nA; cB = nB; ++ui;
        if constexpr (ALIGN_EPI) { if (wr == 1) PG8_BAR; }
    }
    PG8_WAIT_V(0);
    if constexpr (!ALIGN_EPI) { if (wr == 0) PG8_BAR; }
    PG8_BAR;
    if constexpr (Epi::AFTER_DRAIN) E.fused(acc, cur, wr, wc, fr, fq, lds, wid, lane);
#undef PG8_SA
#undef PG8_SB
#undef PG8_STAGE
#undef PG8_LDA
#undef PG8_LDB
#undef PG8_MMA
#undef PG8_WAIT_V
#undef PG8_WAIT_L
#undef PG8_BAR
#undef PG8_SCHED
}

struct EpiProj {
    static constexpr bool PERM = true, AFTER_DRAIN = false, KEEP_ACC = false;
    bf16_t* O; const float* bgate;
    DI void operator()(const Acc& acc, const Unit& u, int wr, int wc, int fr, int fq) const {
        const int row0 = u.pm * BM + wr * 64 + fr, col0 = u.pn * BM + wc * 32 + 8 * fq;
        const bool gate = u.pn >= (C_G / 256);
        f32x4 bv[2][2];
#pragma unroll
        for (int bj = 0; bj < 2; ++bj)
#pragma unroll
            for (int n = 0; n < 2; ++n) bv[bj][n] = gate ? *(const f32x4*)(bgate + (col0 - C_G) + bj * HALF + 4 * n) : (f32x4){0.f, 0.f, 0.f, 0.f};
#pragma unroll
        for (int ai = 0; ai < 2; ++ai)
#pragma unroll
            for (int m = 0; m < 4; ++m) { bf16_t* rowp = O + (size_t)(row0 + ai * HALF + m * 16) * INW + col0;
#pragma unroll
                for (int bj = 0; bj < 2; ++bj) { f32x4 v0 = acc[ai][bj][m][0] + bv[bj][0], v1 = acc[ai][bj][m][1] + bv[bj][1];
                    if (gate) {
#pragma unroll
                        for (int e = 0; e < 4; ++e) { v0[e] = frcp(1.f + fexp2(-v0[e] * LOG2E)); v1[e] = frcp(1.f + fexp2(-v1[e] * LOG2E)); } }
                    u32x4 w; w.x = pk2(v0[0], v0[1]); w.y = pk2(v0[2], v0[3]); w.z = pk2(v1[0], v1[1]); w.w = pk2(v1[2], v1[3]);
                    *(u32x4*)(rowp + bj * HALF) = w; } }
    }
};
struct EpiBf16 {
    static constexpr bool PERM = true, AFTER_DRAIN = false, KEEP_ACC = false;
    bf16_t* O; int ldc;
    DI void operator()(const Acc& acc, const Unit& u, int wr, int wc, int fr, int fq) const {
        const int row0 = u.pm * BM + wr * 64 + fr, col0 = u.pn * BM + wc * 32 + 8 * fq;
#pragma unroll
        for (int ai = 0; ai < 2; ++ai)
#pragma unroll
            for (int m = 0; m < 4; ++m) { bf16_t* rowp = O + (size_t)(row0 + ai * HALF + m * 16) * ldc + col0;
#pragma unroll
                for (int bj = 0; bj < 2; ++bj) { const f32x4 v0 = acc[ai][bj][m][0], v1 = acc[ai][bj][m][1];
                    u32x4 w; w.x = pk2(v0[0], v0[1]); w.y = pk2(v0[2], v0[3]); w.z = pk2(v1[0], v1[1]); w.w = pk2(v1[2], v1[3]);
                    *(u32x4*)(rowp + bj * HALF) = w; } }
    }
};
struct EpiF32 {
    static constexpr bool PERM = false, AFTER_DRAIN = false, KEEP_ACC = false;
    float* O;
    DI void operator()(const Acc& acc, const Unit& u, int wr, int wc, int fr, int fq) const {
        const int row0 = u.pm * BM + wr * 64 + fr, col0 = u.pn * BM + wc * 32 + 4 * fq;
#pragma unroll
        for (int ai = 0; ai < 2; ++ai)
#pragma unroll
            for (int m = 0; m < 4; ++m) { float* rowp = O + (size_t)(row0 + ai * HALF + m * 16) * DM + col0;
#pragma unroll
                for (int bj = 0; bj < 2; ++bj)
#pragma unroll
                    for (int n = 0; n < 2; ++n) *(f32x4*)(rowp + bj * HALF + n * 16) = acc[ai][bj][m][n]; }
    }
};
DI float dpp_shr1(float oldv, float src) { return __builtin_bit_cast(float, __builtin_amdgcn_update_dpp(__builtin_bit_cast(int, oldv), __builtin_bit_cast(int, src), 0x111, 0xf, 0xf, false)); }
DI float dpp_shr2(float oldv, float src) { return __builtin_bit_cast(float, __builtin_amdgcn_update_dpp(__builtin_bit_cast(int, oldv), __builtin_bit_cast(int, src), 0x112, 0xf, 0xf, false)); }
DI float dpp_ror1(float src) { return __builtin_bit_cast(float, __builtin_amdgcn_update_dpp(0, __builtin_bit_cast(int, src), 0x121, 0xf, 0xf, false)); }
DI float dpp_ror2(float src) { return __builtin_bit_cast(float, __builtin_amdgcn_update_dpp(0, __builtin_bit_cast(int, src), 0x122, 0xf, 0xf, false)); }
DI float gelu_t(float x) { const float z = 1.5957691216057308f * (x + 0.044715f * x * x * x); return x * frcp(1.f + fexp2(-z * LOG2E)); }
struct EpiUpConv {
    static constexpr bool PERM = true, AFTER_DRAIN = false, KEEP_ACC = false;
    bf16_t* ACT; float* RAW; const float* cw; const float* cb;
    DI void operator()(const Acc& acc, const Unit& u, int wr, int wc, int fr, int fq) const { conv<false>(acc, u, wr, wc, fr, fq); }
    template <bool HALFM>
    DI void conv(const Acc& acc, const Unit& u, int wr, int wc, int fr, int fq) const {
        const int ch0 = u.pn * HALF + wc * 32 + 8 * fq;
        const int ic0 = u.pn * BM + wc * 32 + 8 * fq;
#pragma unroll
        for (int n = 0; n < 2; ++n) {
            f32x4 wg[3], wv[3], bg, bv;
#pragma unroll
            for (int k = 0; k < 3; ++k) { wg[k] = *(const f32x4*)(cw + k * UPW + ch0 + 4 * n); wv[k] = *(const f32x4*)(cw + k * UPW + DFF + ch0 + 4 * n); }
            bg = *(const f32x4*)(cb + ch0 + 4 * n); bv = *(const f32x4*)(cb + DFF + ch0 + 4 * n);
#pragma unroll
            for (int ai = 0; ai < 2; ++ai) {
                if (HALFM && ai == 1) continue;
                const int rb = (HALFM && u.mh > 0) ? 1 : 0;
                const int gidx = 4 * u.pm + 2 * (ai + rb) + wr;
                float* rawg = RAW + (size_t)gidx * 4 * UPW + ic0 + 4 * n;
#pragma unroll
                for (int m = 0; m < 4; ++m) {
                    const f32x4 xg = acc[ai][0][m][n], xv = acc[ai][1][m][n];
                    if (m == 0 && fr < 2) { *(f32x4*)(rawg + (size_t)fr * UPW) = xg; *(f32x4*)(rawg + (size_t)fr * UPW + HALF) = xv; }
                    if (m == 3 && fr >= 14) { *(f32x4*)(rawg + (size_t)(fr - 12) * UPW) = xg; *(f32x4*)(rawg + (size_t)(fr - 12) * UPW + HALF) = xv; }
                    float res[4];
#pragma unroll
                    for (int e = 0; e < 4; ++e) {
                        float o1g = 0.f, o2g = 0.f, o1v = 0.f, o2v = 0.f;
                        if (m > 0) { o1g = dpp_ror1(acc[ai][0][m - 1][n][e]); o2g = dpp_ror2(acc[ai][0][m - 1][n][e]); o1v = dpp_ror1(acc[ai][1][m - 1][n][e]); o2v = dpp_ror2(acc[ai][1][m - 1][n][e]); }
                        const float p1g = dpp_shr1(o1g, xg[e]), p2g = dpp_shr2(o2g, xg[e]), p1v = dpp_shr1(o1v, xv[e]), p2v = dpp_shr2(o2v, xv[e]);
                        const float cgv = bg[e] + wg[0][e] * p2g + wg[1][e] * p1g + wg[2][e] * xg[e];
                        const float cvv = bv[e] + wv[0][e] * p2v + wv[1][e] * p1v + wv[2][e] * xv[e];
                        res[e] = gelu_t(cgv) * cvv;
                    }
                    u32x2 w; w.x = pk2(res[0], res[1]); w.y = pk2(res[2], res[3]);
                    *(u32x2*)(ACT + (size_t)(u.pm * BM + (ai + rb) * HALF + wr * 64 + m * 16 + fr) * DFF + ch0 + 4 * n) = w;
                }
            }
        }
    }
};
struct EpiUpConvHalf {
    static constexpr bool PERM = true, AFTER_DRAIN = false, KEEP_ACC = false;
    EpiUpConv E;
    DI void operator()(const Acc& acc, const Unit& u, int wr, int wc, int fr, int fq) const { E.template conv<true>(acc, u, wr, wc, fr, fq); }
};
struct EpiBranch {
    static constexpr bool PERM = true, AFTER_DRAIN = false, KEEP_ACC = true;
    const bf16_t* P; bf16_t* mix;
    DI void operator()(Acc& acc, const Unit& u, int wr, int wc, int fr, int fq) const {
        const int row0 = u.pm * BM + wr * 64 + fr, col0 = u.pn * BM + wc * 32 + 8 * fq;
#pragma unroll
        for (int ai = 0; ai < 2; ++ai) {
            u32x4 ga[4][2], gb[4][2];
#pragma unroll
            for (int m = 0; m < 4; ++m) { const bf16_t* gp = P + (size_t)(row0 + ai * HALF + m * 16) * INW + C_G + u.z * DM + col0;
#pragma unroll
                for (int bj = 0; bj < 2; ++bj) { ga[m][bj] = *(const u32x4*)(gp + bj * HALF); gb[m][bj] = (u.z < 2) ? *(const u32x4*)(gp + DM + bj * HALF) : ga[m][bj]; } }
#pragma unroll
            for (int m = 0; m < 4; ++m) { const size_t row = (size_t)(row0 + ai * HALF + m * 16);
#pragma unroll
                for (int bj = 0; bj < 2; ++bj) {
                    float g[8];
#pragma unroll
                    for (int e = 0; e < 4; ++e) { g[2 * e] = fmaxf(bflo(ga[m][bj][e]), 1e-6f); g[2 * e + 1] = fmaxf(bfhi(ga[m][bj][e]), 1e-6f); }
                    if (u.z < 2) {
#pragma unroll
                        for (int e = 0; e < 4; ++e) { g[2 * e] *= frcp(fmaxf(bflo(gb[m][bj][e]), 1e-6f)); g[2 * e + 1] *= frcp(fmaxf(bfhi(gb[m][bj][e]), 1e-6f)); }
#pragma unroll
                        for (int e = 0; e < 4; ++e) { acc[ai][bj][m][0][e] *= g[e]; acc[ai][bj][m][1][e] *= g[4 + e]; }
                    } else {
                        const f32x4 v0 = acc[ai][bj][m][0], v1 = acc[ai][bj][m][1];
                        u32x4 w; w.x = pk2(v0[0] * g[0], v0[1] * g[1]); w.y = pk2(v0[2] * g[2], v0[3] * g[3]); w.z = pk2(v1[0] * g[4], v1[1] * g[5]); w.w = pk2(v1[2] * g[6], v1[3] * g[7]);
                        *(u32x4*)(mix + row * DM + col0 + bj * HALF) = w;
                    }
                } }
        }
    }
};
struct RowStats {
    float* xbuf;
    unsigned* cnt;
    DI void run(const Acc& v, const Unit& u, int wr, int wc, int fr, int fq, LAS unsigned char* lds, int wid, int lane) const {
        LAS float* Pp = (LAS float*)lds;
        LAS float* S = (LAS float*)(lds + 4096);
#pragma unroll
        for (int ai = 0; ai < 2; ++ai)
#pragma unroll
            for (int m = 0; m < 4; ++m) {
                float q = 0.f;
#pragma unroll
                for (int bj = 0; bj < 2; ++bj)
#pragma unroll
                    for (int n = 0; n < 2; ++n) { const f32x4 x = v[ai][bj][m][n]; q += (x[0] * x[0] + x[1] * x[1]) + (x[2] * x[2] + x[3] * x[3]); }
                q += __shfl_xor(q, 16); q += __shfl_xor(q, 32);
                if (fq == 0) Pp[(ai * HALF + wr * 64 + m * 16 + fr) * 4 + wc] = q;
            }
        asm volatile("s_waitcnt lgkmcnt(0)" ::: "memory"); __builtin_amdgcn_s_barrier(); asm volatile("" ::: "memory");
        const int row = wid * 32 + (lane & 31);
        if (lane < 32) {
            const float t = (Pp[row * 4 + 0] + Pp[row * 4 + 1]) + (Pp[row * 4 + 2] + Pp[row * 4 + 3]);
            __hip_atomic_store(xbuf + (size_t)(u.pm * BM + row) * 8 + u.pn, t, __ATOMIC_RELAXED, __HIP_MEMORY_SCOPE_AGENT);
        }
        asm volatile("s_waitcnt vmcnt(0)" ::: "memory");
        if (lane == 0) __hip_atomic_fetch_add(cnt + 64 * u.pm, 1u, __ATOMIC_RELAXED, __HIP_MEMORY_SCOPE_AGENT);
        if (wid == 0) {
            unsigned spin = 0;
            while ((unsigned)__builtin_amdgcn_readfirstlane(__hip_atomic_load(cnt + 64 * u.pm, __ATOMIC_RELAXED, __HIP_MEMORY_SCOPE_AGENT)) < 64u) { __builtin_amdgcn_s_sleep(1); if (++spin > (1u << 22)) break; }
        }
        asm volatile("s_waitcnt vmcnt(0) lgkmcnt(0)" ::: "memory"); __builtin_amdgcn_s_barrier(); asm volatile("" ::: "memory");
        if (lane < 32) {
            const float* slot = xbuf + (size_t)(u.pm * BM + row) * 8; float t = 0.f;
#pragma unroll
            for (int k = 0; k < 8; ++k) t += __hip_atomic_load(slot + k, __ATOMIC_RELAXED, __HIP_MEMORY_SCOPE_AGENT);
            S[row] = rsqrtf(t * (1.f / DM) + EPS);
        }
        asm volatile("s_waitcnt lgkmcnt(0)" ::: "memory"); __builtin_amdgcn_s_barrier(); asm volatile("" ::: "memory");
    }
};
struct EpiNormRes {
    static constexpr bool PERM = false, AFTER_DRAIN = true, KEEP_ACC = false;
    const float* xin; float* xout; bf16_t* xn; const float* gpost; const float* gpre; RowStats st1, st2;
    DI void operator()(const Acc&, const Unit&, int, int, int, int) const {}
    DI void fused(Acc& acc, const Unit& u, int wr, int wc, int fr, int fq, LAS unsigned char* lds, int wid, int lane) const {
        const LAS float* S = (const LAS float*)(lds + 4096);
        const int col0 = u.pn * BM + wc * 32 + 4 * fq;
        f32x4 pre[4][2][2];
        LAS float* GL = (LAS float*)(lds + 8192);
        { const int t = wid * 64 + lane; if (t < 64) *(LAS f32x4*)(GL + 4 * t) = *(const f32x4*)(gpost + u.pn * BM + 4 * t); else if (t < 128 && xn) *(LAS f32x4*)(GL + 4 * t) = *(const f32x4*)(gpre + u.pn * BM + 4 * (t - 64)); }
        const int lc0 = wc * 32 + 4 * fq;
#pragma unroll
        for (int m = 0; m < 4; ++m) { const size_t off = (size_t)(u.pm * BM + wr * 64 + m * 16 + fr) * DM + col0;
#pragma unroll
            for (int bj = 0; bj < 2; ++bj)
#pragma unroll
                for (int n = 0; n < 2; ++n) pre[m][bj][n] = *(const f32x4*)(xin + off + bj * HALF + n * 16); }
        st1.run(acc, u, wr, wc, fr, fq, lds, wid, lane);
#pragma unroll
        for (int ai = 0; ai < 2; ++ai) {
            if (ai == 1) {
#pragma unroll
                for (int m = 0; m < 4; ++m) { const size_t off = (size_t)(u.pm * BM + HALF + wr * 64 + m * 16 + fr) * DM + col0;
#pragma unroll
                    for (int bj = 0; bj < 2; ++bj)
#pragma unroll
                        for (int n = 0; n < 2; ++n) pre[m][bj][n] = *(const f32x4*)(xin + off + bj * HALF + n * 16); }
            }
#pragma unroll
            for (int m = 0; m < 4; ++m) { const int r = ai * HALF + wr * 64 + m * 16 + fr; const float rs = S[r]; const size_t off = (size_t)(u.pm * BM + r) * DM + col0;
                const LAS float* gl = GL + lc0; asm volatile("" : "+v"(gl));
#pragma unroll
                for (int bj = 0; bj < 2; ++bj)
#pragma unroll
                    for (int n = 0; n < 2; ++n) { const f32x4 gv = *(const LAS f32x4*)(gl + bj * HALF + n * 16); const f32x4 o = pre[m][bj][n] + acc[ai][bj][m][n] * rs * gv; acc[ai][bj][m][n] = o; *(f32x4*)(xout + off + bj * HALF + n * 16) = o; } }
        }
        if (xn) {
            st2.run(acc, u, wr, wc, fr, fq, lds, wid, lane);
#pragma unroll
            for (int ai = 0; ai < 2; ++ai)
#pragma unroll
                for (int m = 0; m < 4; ++m) { const int r = ai * HALF + wr * 64 + m * 16 + fr; const float rs = S[r]; const size_t off = (size_t)(u.pm * BM + r) * DM + col0;
                    const LAS float* gl = GL + 256 + lc0; asm volatile("" : "+v"(gl));
#pragma unroll
                    for (int bj = 0; bj < 2; ++bj)
#pragma unroll
                        for (int n = 0; n < 2; ++n) { const f32x4 gv = *(const LAS f32x4*)(gl + bj * HALF + n * 16); const f32x4 o = acc[ai][bj][m][n] * rs * gv;
                            u32x2 w; w.x = pk2(o[0], o[1]); w.y = pk2(o[2], o[3]); *(u32x2*)(xn + off + bj * HALF + n * 16) = w; } }
        }
    }
};
}

constexpr int KP = 144, VP = 136;
constexpr int AT_EXT = 107520, AT_SEL = 74752, AT_KM = 75776, AT_PARTS = 77824, AT_MISC = 106496;
DI f32x16 mfma32(bf16x8 a, bf16x8 b, f32x16 c) { return __builtin_amdgcn_mfma_f32_32x32x16_bf16(a, b, c, 0, 0, 0); }

template <int DV>
DI void wave_tile(const LAS unsigned char* Kl, const LAS unsigned char* Vl, const LAS float* tbp, const bf16x8 (&qf)[4], f32x16 (&o)[DV / 32], float& m, float& l,
                  int r, int h, bool near, float cadd) {
    f32x16 s[2];
#pragma unroll
    for (int kh = 0; kh < 2; ++kh) {
        f32x16 a;
#pragma unroll
        for (int i = 0; i < 16; ++i) a[i] = 0.f;
#pragma unroll
        for (int ks = 0; ks < 4; ++ks) { const bf16x8 kf = *(const LAS bf16x8*)(Kl + (32 * kh + r) * KP + (16 * ks + 8 * h) * 2); a = mfma32(kf, qf[ks], a); }
        s[kh] = a;
    }
    float mx = -INFINITY;
    if (near) {
#pragma unroll
        for (int kh = 0; kh < 2; ++kh)
#pragma unroll
            for (int i = 0; i < 16; ++i) {
                const float v = s[kh][i] * SC2 + tbp[59 - (32 * kh + (i & 3) + 8 * (i >> 2))];
                s[kh][i] = v; mx = fmaxf(mx, v);
                if ((i & 7) == 7) __builtin_amdgcn_sched_barrier(0);
            }
    } else {
#pragma unroll
        for (int kh = 0; kh < 2; ++kh)
#pragma unroll
            for (int i = 0; i < 16; ++i) mx = fmaxf(mx, s[kh][i]);
        mx = mx * SC2 + cadd;
    }
    mx = fmaxf(mx, __shfl_xor(mx, 32));
    const float mn = fmaxf(m, mx);
    const float mu = (mn == -INFINITY) ? 0.f : mn;
    if (__ballot(mn > m) != 0ull) {
        const float alpha = fexp2(m - mu);
        l *= alpha;
#pragma unroll
        for (int d = 0; d < DV / 32; ++d) o[d] *= alpha;
    }
    m = mn;
    float ps = 0.f;
    if (near) {
#pragma unroll
        for (int kh = 0; kh < 2; ++kh)
#pragma unroll
            for (int i = 0; i < 16; ++i) { const float p = fexp2(s[kh][i] - mu); s[kh][i] = p; ps += p; }
    } else {
        const float c2 = cadd - mu;
#pragma unroll
        for (int kh = 0; kh < 2; ++kh)
#pragma unroll
            for (int i = 0; i < 16; ++i) { const float p = fexp2(s[kh][i] * SC2 + c2); s[kh][i] = p; ps += p; }
    }
    l += ps;
#pragma unroll
    for (int kh = 0; kh < 2; ++kh)
#pragma unroll
        for (int st = 0; st < 2; ++st) {
            u32x4 pw; pw.x = pk2(s[kh][8 * st + 0], s[kh][8 * st + 1]); pw.y = pk2(s[kh][8 * st + 2], s[kh][8 * st + 3]);
            pw.z = pk2(s[kh][8 * st + 4], s[kh][8 * st + 5]); pw.w = pk2(s[kh][8 * st + 6], s[kh][8 * st + 7]);
            const bf16x8 pf = __builtin_bit_cast(bf16x8, pw);
#pragma unroll
            for (int d = 0; d < DV / 32; ++d) {
                const LAS unsigned char* vp = Vl + (32 * d + r) * VP + (32 * kh + 16 * st + 4 * h) * 2;
                const s16x4 lo = *(const LAS s16x4*)vp, hi4 = *(const LAS s16x4*)(vp + 16);
                const bf16x8 vf = __builtin_shufflevector(lo, hi4, 0, 1, 2, 3, 4, 5, 6, 7);
                o[d] = mfma32(vf, pf, o[d]);
            }
            __builtin_amdgcn_sched_barrier(0);
        }
}

struct AttnCtx {
    const bf16_t* Pp; bf16_t* Yp; const float* tabp;
    const float *lq1, *lk1, *lq2, *lk2, *subg, *sinks;
    float lam_init;
};

template <int KIND>
ATTN_INL void attn_unit(int tid, LAS unsigned char* lds, const AttnCtx& C, int b, int hd, int blk) {
    constexpr int DV = KIND == 0 ? 128 : 64, NKB = KIND == 0 ? 2 : 1, NV = DV / 64;
    constexpr int KBB = 64 * KP, STG = NKB * KBB + DV * VP;
    const int lane = tid & 63, r = lane & 31, h = lane >> 5, w = __builtin_amdgcn_readfirstlane(tid >> 6);
    const size_t tokb = (size_t)b * SEQ;
    const bf16_t* Pb = C.Pp + tokb * INW;
    LAS float* ext = (LAS float*)(lds + AT_EXT);
    int qcol, kcol, vcol, ycol, bh, q0, qw0, t0, t1, kbsel = 0;
    if (KIND == 0) { const int mp = w >> 2; qcol = C_QA + hd * 128 + mp * 64; kcol = C_KA + hd * 128; vcol = C_VA + hd * 128; ycol = hd * 128; bh = hd; q0 = blk * 128; qw0 = q0 + 32 * (w & 3); t0 = 0; t1 = 2 * (blk + 1); kbsel = mp; }
    else if (KIND == 1) { qcol = C_QB + hd * 64; kcol = C_KB + (hd >> 2) * 64; vcol = C_VB + (hd >> 2) * 64; ycol = 512 + hd * 64; bh = 4 + hd; q0 = blk * 256; qw0 = q0 + 32 * w; t0 = (q0 >= 128 ? q0 - 128 : 0) / 64; t1 = (q0 + 256) / 64; }
    else { qcol = C_QC + hd * 64; kcol = C_KC + hd * 64; vcol = C_VC + hd * 64; ycol = 1024 + hd * 64; bh = 12 + hd; q0 = blk * 256; qw0 = q0 + 32 * w; t0 = 0; t1 = 4 * (blk + 1); }

    bf16x8 qf[4];
    { const bf16_t* qp = Pb + (size_t)(qw0 + r) * INW + qcol + 8 * h;
#pragma unroll
      for (int ks = 0; ks < 4; ++ks) qf[ks] = *(const bf16x8*)(qp + 16 * ks); }
    __syncthreads();
    if (tid < 320) { const int dist = tid - 96; const int di = dist < 0 ? 0 : (dist > 128 ? 128 : dist);
        const float tv = C.tabp[bh * TABN + di];
        ext[tid] = (dist < 0 || (KIND == 1 && dist >= 128)) ? -INFINITY : tv; ext[320 + tid] = -INFINITY; }
    unsigned selmask = 0xffu;
    if (KIND == 2) {
        const int ob = blk;
        LAS float* parts = (LAS float*)(lds + AT_PARTS);
        LAS float* km = (LAS float*)(lds + AT_KM);
        LAS unsigned char* sel = lds + AT_SEL;
        {
            const int d2 = tid & 31, kp = tid >> 5;
            for (int j = 0; j < ob; j += 2) {
                const bf16_t* kb = Pb + (size_t)(j * 256 + kp * 16) * INW + kcol + 2 * d2;
                const bool two = j + 1 < ob;
                unsigned wa[16], wb[16];
#pragma unroll
                for (int k = 0; k < 16; ++k) { wa[k] = *(const unsigned*)(kb + (size_t)k * INW); wb[k] = two ? *(const unsigned*)(kb + (size_t)(256 + k) * INW) : 0u; }
                float s0 = 0.f, s1 = 0.f, t0 = 0.f, t1 = 0.f;
#pragma unroll
                for (int k = 0; k < 16; ++k) { s0 += bflo(wa[k]); s1 += bfhi(wa[k]); t0 += bflo(wb[k]); t1 += bfhi(wb[k]); }
                parts[(j * 16 + kp) * 64 + 2 * d2] = s0; parts[(j * 16 + kp) * 64 + 2 * d2 + 1] = s1;
                if (two) { parts[((j + 1) * 16 + kp) * 64 + 2 * d2] = t0; parts[((j + 1) * 16 + kp) * 64 + 2 * d2 + 1] = t1; }
            }
        }
        __syncthreads();
        if (tid < ob * 64) { const int j = tid >> 6, d = tid & 63; float s = 0.f;
#pragma unroll
            for (int k = 0; k < 16; ++k) s += parts[(j * 16 + k) * 64 + d];
            km[j * 64 + d] = s * (1.f / 256.f); }
        __syncthreads();
        {
            const int qi = tid >> 1, hf = tid & 1;
            const bf16_t* qp = Pb + (size_t)(q0 + qi) * INW + qcol + 32 * hf;
            float qv[32];
#pragma unroll
            for (int c = 0; c < 4; ++c) { const u32x4 wv = *(const u32x4*)(qp + 8 * c);
                qv[8 * c + 0] = bflo(wv.x); qv[8 * c + 1] = bfhi(wv.x); qv[8 * c + 2] = bflo(wv.y); qv[8 * c + 3] = bfhi(wv.y);
                qv[8 * c + 4] = bflo(wv.z); qv[8 * c + 5] = bfhi(wv.z); qv[8 * c + 6] = bflo(wv.w); qv[8 * c + 7] = bfhi(wv.w); }
            float gt[7];
#pragma unroll
            for (int j = 0; j < 7; ++j) { float s = 0.f;
                if (j < ob) {
#pragma unroll
                    for (int d = 0; d < 32; ++d) s += qv[d] * km[j * 64 + 32 * hf + d]; }
                s += __shfl_xor(s, 1); gt[j] = s; }
            unsigned msk = 0;
#pragma unroll
            for (int j = 0; j < 7; ++j) { int rank = 0;
#pragma unroll
                for (int i = 0; i < 7; ++i) if (i != j && i < ob) rank += (gt[i] > gt[j] || (gt[i] == gt[j] && i < j)) ? 1 : 0;
                if (j < ob && rank < 3) msk |= 1u << j; }
            if (hf == 0) sel[qi] = (unsigned char)msk;
        }
        __syncthreads();
        selmask = sel[32 * w + r];
    }
    asm volatile("" : "+v"(qf[0]), "+v"(qf[1]), "+v"(qf[2]), "+v"(qf[3]));
    f32x16 o[DV / 32];
#pragma unroll
    for (int d = 0; d < DV / 32; ++d)
#pragma unroll
        for (int i = 0; i < 16; ++i) o[d][i] = 0.f;
    float mrun = -INFINITY, lrun = 0.f;
    const int skey = tid >> 3, sc = tid & 7;
    const int vkey = tid & 63, vc0 = tid >> 6;
    u32x4 kreg[NKB], vreg[NV];
#define AT_LOAD(t) do { const bf16_t* kb_ = Pb + (size_t)((t) * 64 + skey) * INW + kcol + 8 * sc; \
        _Pragma("unroll") for (int nb = 0; nb < NKB; ++nb) kreg[nb] = *(const u32x4*)(kb_ + 64 * nb); \
        const bf16_t* vb_ = Pb + (size_t)((t) * 64 + vkey) * INW + vcol + 8 * vc0; \
        _Pragma("unroll") for (int i = 0; i < NV; ++i) vreg[i] = *(const u32x4*)(vb_ + 64 * i); } while (0)
#define AT_STORE(stg) do { LAS unsigned char* sb_ = lds + (stg) * STG; \
        _Pragma("unroll") for (int nb = 0; nb < NKB; ++nb) *(LAS u32x4*)(sb_ + nb * KBB + skey * KP + 16 * sc) = kreg[nb]; \
        _Pragma("unroll") for (int i = 0; i < NV; ++i) { LAS unsigned char* vt_ = sb_ + NKB * KBB + (8 * (vc0 + 8 * i)) * VP + 2 * vkey; \
            *(LAS unsigned short*)(vt_ + 0 * VP) = (unsigned short)(vreg[i].x & 0xffffu); *(LAS unsigned short*)(vt_ + 1 * VP) = (unsigned short)(vreg[i].x >> 16); \
            *(LAS unsigned short*)(vt_ + 2 * VP) = (unsigned short)(vreg[i].y & 0xffffu); *(LAS unsigned short*)(vt_ + 3 * VP) = (unsigned short)(vreg[i].y >> 16); \
            *(LAS unsigned short*)(vt_ + 4 * VP) = (unsigned short)(vreg[i].z & 0xffffu); *(LAS unsigned short*)(vt_ + 5 * VP) = (unsigned short)(vreg[i].z >> 16); \
            *(LAS unsigned short*)(vt_ + 6 * VP) = (unsigned short)(vreg[i].w & 0xffffu); *(LAS unsigned short*)(vt_ + 7 * VP) = (unsigned short)(vreg[i].w >> 16); } } while (0)
    AT_LOAD(t0); AT_STORE(0);
    __syncthreads();
    const float cfar = ext[96 + 128];
    for (int t = t0; t < t1; ++t) {
        const int stg = (t - t0) & 1;
        if (t + 1 < t1) AT_LOAD(t + 1);
        {
            const int key0 = t * 64;
            bool skip, near, lv = true;
            if (KIND == 0) { skip = key0 > qw0 + 31; near = key0 > qw0 - 191; }
            else if (KIND == 1) { skip = (key0 > qw0 + 31) || (key0 + 63 < qw0 - 127); near = true; }
            else { if (t < 4 * blk) { lv = (selmask >> (t >> 2)) & 1u; skip = __ballot(lv) == 0ull; near = key0 > qw0 - 191; } else { skip = key0 > qw0 + 31; near = key0 > qw0 - 191; } }
            if (!skip) {
                const LAS unsigned char* sb = lds + stg * STG;
                const LAS float* tbp = ext + (lv ? 0 : 320) + (qw0 + r - key0 - 4 * h + 96 - 59);
                wave_tile<DV>(sb + kbsel * KBB, sb + NKB * KBB, tbp, qf, o, mrun, lrun, r, h, near, lv ? cfar : -INFINITY);
            }
        }
        if (t + 1 < t1) AT_STORE(stg ^ 1);
        __syncthreads();
    }
#undef AT_LOAD
#undef AT_STORE
    float ltot = lrun + __shfl_xor(lrun, 32);
    if (KIND == 1) ltot += fexp2(C.sinks[hd] * LOG2E - mrun);
    const float inv = 1.f / ltot;
    bf16_t* yrow = C.Yp + (tokb + qw0 + r) * YW + ycol;
    if (KIND != 0) {
#pragma unroll
        for (int d = 0; d < 2; ++d)
#pragma unroll
            for (int g = 0; g < 4; ++g) { u32x2 wv; wv.x = pk2(o[d][4 * g] * inv, o[d][4 * g + 1] * inv); wv.y = pk2(o[d][4 * g + 2] * inv, o[d][4 * g + 3] * inv);
                *(u32x2*)(yrow + 32 * d + 8 * g + 4 * h) = wv; }
    } else {
        const float s1 = wave_sum(C.lq1[lane] * C.lk1[lane]), s2 = wave_sum(C.lq2[lane] * C.lk2[lane]);
        const float lam = __expf(s1) - __expf(s2) + C.lam_init;
        LAS float* X = (LAS float*)lds;
        const int qi = 32 * (w & 3) + r;
        if (w >= 4) {
#pragma unroll
            for (int d = 0; d < 4; ++d)
#pragma unroll
                for (int g = 0; g < 4; ++g) *(LAS f32x4*)(X + qi * 132 + 32 * d + 8 * g + 4 * h) = (f32x4){o[d][4 * g] * inv, o[d][4 * g + 1] * inv, o[d][4 * g + 2] * inv, o[d][4 * g + 3] * inv};
        }
        __syncthreads();
        if (w < 4) {
            float ss = 0.f;
#pragma unroll
            for (int d = 0; d < 4; ++d)
#pragma unroll
                for (int g = 0; g < 4; ++g) { const f32x4 o2 = *(const LAS f32x4*)(X + qi * 132 + 32 * d + 8 * g + 4 * h);
#pragma unroll
                    for (int e = 0; e < 4; ++e) { const float v = o[d][4 * g + e] * inv - lam * o2[e]; o[d][4 * g + e] = v; ss += v * v; } }
            ss += __shfl_xor(ss, 32);
            const float rs = rsqrtf(ss * (1.f / 128.f) + EPS) * (1.f - C.lam_init);
#pragma unroll
            for (int d = 0; d < 4; ++d)
#pragma unroll
                for (int g = 0; g < 4; ++g) { const int dc = 32 * d + 8 * g + 4 * h; const f32x4 gg = *(const f32x4*)(C.subg + dc);
                    u32x2 wv; wv.x = pk2(o[d][4 * g] * rs * gg[0], o[d][4 * g + 1] * rs * gg[1]); wv.y = pk2(o[d][4 * g + 2] * rs * gg[2], o[d][4 * g + 3] * rs * gg[3]);
                    *(u32x2*)(yrow + dc) = wv; }
        }
    }
}

DI void attn_phase(int tid, LAS unsigned char* lds, const AttnCtx& C, unsigned* ctr, int kindsel) {
    LAS int* nxt = (LAS int*)(lds + AT_MISC);
    for (;;) {
        __syncthreads();
        if (tid == 0) nxt[0] = (int)atomicAdd(ctr, 1u);
        __syncthreads();
        const int i = __builtin_amdgcn_readfirstlane(nxt[0]);
        if (i >= 768) break;
        int tl = tid; asm volatile("" : "+v"(tl));
        if (i < 512) {
            const int g = i >> 6, j = i & 63;
            int bb, hh, kk;
            if (j < 16) { bb = j >> 2; hh = j & 3; kk = 15 - 2 * g; } else if (j >= 48) { bb = (j - 48) >> 2; hh = (j - 48) & 3; kk = 14 - 2 * g; } else { bb = (j - 16) >> 3; hh = (j - 16) & 7; kk = 7 - g; }
            if (j < 16 || j >= 48) { if (kindsel & 1) attn_unit<0>(tl, lds, C, bb, hh, kk); }
            else { if (kindsel & 4) attn_unit<2>(tl, lds, C, bb, hh, kk); }
        } else {
            const int j = i - 512; if (kindsel & 2) attn_unit<1>(tl, lds, C, j >> 6, (j >> 3) & 7, j & 7);
        }
    }
}

DI void row_phase(int gw, int NGW, int lane, const float* xin, const float* y, const float* gpost, const float* gpre, float* xout, bf16_t* xn) {
    for (int m = gw; m < M; m += NGW) {
        const f32x4* xr = (const f32x4*)(xin + (size_t)m * DM) + lane;
        f32x4 v[8];
#pragma unroll
        for (int j = 0; j < 8; ++j) v[j] = xr[64 * j];
        if (y) {
            const f32x4* yr = (const f32x4*)(y + (size_t)m * DM) + lane;
            f32x4 wv[8]; float ss = 0.f;
#pragma unroll
            for (int j = 0; j < 8; ++j) { wv[j] = yr[64 * j]; ss += (wv[j][0] * wv[j][0] + wv[j][1] * wv[j][1]) + (wv[j][2] * wv[j][2] + wv[j][3] * wv[j][3]); }
            const float rs = rsqrtf(wave_sum(ss) * (1.f / DM) + EPS);
            f32x4* xo = (f32x4*)(xout + (size_t)m * DM) + lane;
#pragma unroll
            for (int j = 0; j < 8; ++j) { const f32x4 gp = ((const f32x4*)gpost)[lane + 64 * j]; v[j] += wv[j] * rs * gp; xo[64 * j] = v[j]; }
        }
        if (xn) {
            float ss = 0.f;
#pragma unroll
            for (int j = 0; j < 8; ++j) ss += (v[j][0] * v[j][0] + v[j][1] * v[j][1]) + (v[j][2] * v[j][2] + v[j][3] * v[j][3]);
            const float rs = rsqrtf(wave_sum(ss) * (1.f / DM) + EPS);
            u32x2* xo = (u32x2*)(xn + (size_t)m * DM) + lane;
#pragma unroll
            for (int j = 0; j < 8; ++j) { const f32x4 gp = ((const f32x4*)gpre)[lane + 64 * j]; const f32x4 t = v[j] * rs * gp;
                u32x2 wv; wv.x = pk2(t[0], t[1]); wv.y = pk2(t[2], t[3]); xo[64 * j] = wv; }
        }
    }
}
DI float gelu_tanh(float x) {
    const float z = 1.5957691216057308f * (x + 0.044715f * x * x * x);
    return x * frcp(1.f + fexp2(-z * LOG2E));
}
DI void conv_phase(int gt, int NGT, const bf16_t* U, const float* cw, const float* cb, bf16_t* ACT) {
    constexpr int NCG = DFF / 8, NRC = M / 16;
    for (int it = gt; it < NRC * NCG; it += NGT) {
        const int cgp = it % NCG, rc = it / NCG, tt0 = rc * 16, j0 = cgp * 8;
        float wg[3][8], wv[3][8], bg[8], bvl[8];
#pragma unroll
        for (int k = 0; k < 3; ++k)
#pragma unroll
            for (int e = 0; e < 8; e += 4) { const f32x4 a = *(const f32x4*)(cw + k * UPW + j0 + e), c = *(const f32x4*)(cw + k * UPW + DFF + j0 + e);
#pragma unroll
                for (int q = 0; q < 4; ++q) { wg[k][e + q] = a[q]; wv[k][e + q] = c[q]; } }
#pragma unroll
        for (int e = 0; e < 8; e += 4) { const f32x4 a = *(const f32x4*)(cb + j0 + e), c = *(const f32x4*)(cb + DFF + j0 + e);
#pragma unroll
            for (int q = 0; q < 4; ++q) { bg[e + q] = a[q]; bvl[e + q] = c[q]; } }
        const bf16_t* ug = U + (size_t)tt0 * UPW + j0;
        u32x4 g2 = {0, 0, 0, 0}, g1 = g2, v2 = g2, v1 = g2;
        if ((tt0 & (SEQ - 1)) != 0) { g2 = *(const u32x4*)(ug - 2 * (size_t)UPW); g1 = *(const u32x4*)(ug - (size_t)UPW); v2 = *(const u32x4*)(ug - 2 * (size_t)UPW + DFF); v1 = *(const u32x4*)(ug - (size_t)UPW + DFF); }
#pragma unroll 4
        for (int rr = 0; rr < 16; ++rr) {
            const u32x4 g0 = *(const u32x4*)(ug + (size_t)rr * UPW), v0 = *(const u32x4*)(ug + (size_t)rr * UPW + DFF);
            float res[8];
#pragma unroll
            for (int e = 0; e < 4; ++e) {
                const float a0 = bg[2 * e] + wg[0][2 * e] * bflo(g2[e]) + wg[1][2 * e] * bflo(g1[e]) + wg[2][2 * e] * bflo(g0[e]);
                const float a1 = bg[2 * e + 1] + wg[0][2 * e + 1] * bfhi(g2[e]) + wg[1][2 * e + 1] * bfhi(g1[e]) + wg[2][2 * e + 1] * bfhi(g0[e]);
                const float c0 = bvl[2 * e] + wv[0][2 * e] * bflo(v2[e]) + wv[1][2 * e] * bflo(v1[e]) + wv[2][2 * e] * bflo(v0[e]);
                const float c1 = bvl[2 * e + 1] + wv[0][2 * e + 1] * bfhi(v2[e]) + wv[1][2 * e + 1] * bfhi(v1[e]) + wv[2][2 * e + 1] * bfhi(v0[e]);
                res[2 * e] = gelu_tanh(a0) * c0; res[2 * e + 1] = gelu_tanh(a1) * c1;
            }
            u32x4 ow; ow.x = pk2(res[0], res[1]); ow.y = pk2(res[2], res[3]); ow.z = pk2(res[4], res[5]); ow.w = pk2(res[6], res[7]);
            *(u32x4*)(ACT + (size_t)(tt0 + rr) * DFF + j0) = ow;
            g2 = g1; g1 = g0; v2 = v1; v1 = v0;
        }
    }
}

DI void conv_fix_phase(int gt, int NGT, const float* RAW, const float* cw, const float* cb, bf16_t* ACT) {
    constexpr int NC4 = DFF / 4;
    for (int it = gt; it < (M / 64) * 2 * NC4; it += NGT) {
        const int c4 = it % NC4, rr = (it / NC4) & 1, gidx = it / (2 * NC4), j0 = 4 * c4, ic = 256 * (j0 >> 7) + (j0 & 127);
        const bool hasprev = (gidx & 31) != 0;
        const float* own = RAW + (size_t)gidx * 4 * UPW + ic; const float* prv = own - (size_t)4 * UPW;
        const f32x4 z4 = {0.f, 0.f, 0.f, 0.f};
        f32x4 x0g, x1g, x2g, x0v, x1v, x2v;
        x0g = *(const f32x4*)(own + (size_t)rr * UPW); x0v = *(const f32x4*)(own + (size_t)rr * UPW + 128);
        if (rr) { x1g = *(const f32x4*)(own); x1v = *(const f32x4*)(own + 128); x2g = hasprev ? *(const f32x4*)(prv + (size_t)3 * UPW) : z4; x2v = hasprev ? *(const f32x4*)(prv + (size_t)3 * UPW + 128) : z4; }
        else { x1g = hasprev ? *(const f32x4*)(prv + (size_t)3 * UPW) : z4; x1v = hasprev ? *(const f32x4*)(prv + (size_t)3 * UPW + 128) : z4;
               x2g = hasprev ? *(const f32x4*)(prv + (size_t)2 * UPW) : z4; x2v = hasprev ? *(const f32x4*)(prv + (size_t)2 * UPW + 128) : z4; }
        float res[4];
        const f32x4 bg = *(const f32x4*)(cb + j0), bv = *(const f32x4*)(cb + DFF + j0);
        const f32x4 w0g = *(const f32x4*)(cw + j0), w1g = *(const f32x4*)(cw + UPW + j0), w2g = *(const f32x4*)(cw + 2 * UPW + j0);
        const f32x4 w0v = *(const f32x4*)(cw + DFF + j0), w1v = *(const f32x4*)(cw + UPW + DFF + j0), w2v = *(const f32x4*)(cw + 2 * UPW + DFF + j0);
#pragma unroll
        for (int e = 0; e < 4; ++e) { const float cgv = bg[e] + w0g[e] * x2g[e] + w1g[e] * x1g[e] + w2g[e] * x0g[e], cvv = bv[e] + w0v[e] * x2v[e] + w1v[e] * x1v[e] + w2v[e] * x0v[e];
            res[e] = pg8::gelu_t(cgv) * cvv; }
        u32x2 w; w.x = pk2(res[0], res[1]); w.y = pk2(res[2], res[3]);
        *(u32x2*)(ACT + (size_t)(gidx * 64 + rr) * DFF + j0) = w;
    }
}

template <bool UPMAP = false>
DI void transpose_item(const float* W, int K, int N, bf16_t* WT, LAS float* scr, int item, int lane) {
    const int nblk = N / 32, kb = item / nblk, nb = item % nblk, k0 = 64 * kb, n0 = 32 * nb;
    int r0 = n0;
    if (UPMAP) { const int j = n0 >= DFF ? n0 - DFF : n0; r0 = 256 * (j >> 7) + (j & 127) + (n0 >= DFF ? 128 : 0); }
    float v[32];
    const float* src = W + (size_t)(k0 + (lane >> 5)) * N + n0 + (lane & 31);
#pragma unroll
    for (int i = 0; i < 32; ++i) v[i] = src[(size_t)(2 * i) * N];
#pragma unroll
    for (int i = 0; i < 32; ++i) scr[(2 * i + (lane >> 5)) * 33 + (lane & 31)] = v[i];
    asm volatile("s_waitcnt lgkmcnt(0)" ::: "memory");
    const int c = lane & 7;
#pragma unroll
    for (int j = 0; j < 4; ++j) { const int n = (lane >> 3) + 8 * j; const LAS float* s = scr + (8 * c) * 33 + n;
        u32x4 o; o.x = pk2(s[0 * 33], s[1 * 33]); o.y = pk2(s[2 * 33], s[3 * 33]); o.z = pk2(s[4 * 33], s[5 * 33]); o.w = pk2(s[6 * 33], s[7 * 33]);
        *(u32x4*)(WT + (size_t)(r0 + n) * K + k0 + 8 * c) = o; }
    asm volatile("s_waitcnt lgkmcnt(0)" ::: "memory");
}

#define XB_TMO      128
#define XB_XCNT(j)  (256  + 64 * (j))
#define XB_XSUB(j)  (1280 + 64 * (j))
#define XB_XGEN(j)  (2304 + 64 * (j))
#define XB_TOP      3328
#define XB_TOPGEN   3392
#define XCD_BAR_WORDS 3456
#define XB_SPIN_CAP (1u << 22)
constexpr int CW_BAR = 4096;
DI unsigned xb_ld(unsigned* p)              { return __hip_atomic_load(p, __ATOMIC_RELAXED, __HIP_MEMORY_SCOPE_AGENT); }
DI unsigned xb_add(unsigned* p, unsigned v) { return __hip_atomic_fetch_add(p, v, __ATOMIC_RELAXED, __HIP_MEMORY_SCOPE_AGENT); }
DI unsigned xb_xcc_id() { return (unsigned)__builtin_amdgcn_s_getreg((3 << 11) | 20) & 0xFu; }
#define XB_SPIN(cond, bar) do { unsigned _sp = 0; while (cond) { __builtin_amdgcn_s_sleep(1); \
    if ((++_sp & 255u) == 0u) { if (xb_ld(&(bar)[XB_TMO])) break; if (_sp > XB_SPIN_CAP) { atomicAdd(&(bar)[XB_TMO], 1u); break; } } } } while (0)
struct XcdBarrier { unsigned* bar; unsigned x; volatile LAS unsigned* st; };
DI XcdBarrier xcd_barrier_post(unsigned* bar, volatile LAS unsigned* st) {
    XcdBarrier b; b.bar = bar; b.x = xb_xcc_id(); b.st = st;
    if (threadIdx.x == 0) (void)xb_add(&bar[XB_XCNT(b.x)], 1u);
    return b;
}
DI void xcd_barrier_complete(unsigned* bar, unsigned x, unsigned& nloc, unsigned& nx) {
    const unsigned G = gridDim.x * gridDim.y * gridDim.z;
    unsigned sum, cnt, mine, sp = 0u;
    for (;;) {
        sum = 0u; cnt = 0u; mine = 0u;
#pragma unroll
        for (unsigned j = 0; j < 16; ++j) { const unsigned c = xb_ld(&bar[XB_XCNT(j)]); sum += c; cnt += (c > 0u) ? 1u : 0u; mine = (j == x) ? c : mine; }
        if (sum == G) break;
        __builtin_amdgcn_s_sleep(1);
        if ((++sp & 255u) == 0u) { if (xb_ld(&bar[XB_TMO])) break; if (sp > XB_SPIN_CAP) { atomicAdd(&bar[XB_TMO], 1u); break; } }
    }
    nloc = mine > 0u ? mine : 1u; nx = cnt > 0u ? cnt : 1u;
}
DI void xcd_barrier(const XcdBarrier& b) {
    asm volatile("s_waitcnt vmcnt(0)" ::: "memory");
    __syncthreads();
    if (threadIdx.x == 0) {
        unsigned* bar = b.bar;
        __builtin_amdgcn_s_waitcnt(0);
        unsigned nloc = b.st[0], nx = b.st[1];
        if (nloc == 0u) { xcd_barrier_complete(bar, b.x, nloc, nx); b.st[0] = nloc; b.st[1] = nx; }
        const unsigned old = xb_add(&bar[XB_XSUB(b.x)], 1u);
        const unsigned gen = old / nloc;
        if (old + 1u == (gen + 1u) * nloc) {
            __builtin_amdgcn_fence(__ATOMIC_RELEASE, "agent");
            asm volatile("s_waitcnt vmcnt(0)" ::: "memory");
            const unsigned og = xb_add(&bar[XB_TOP], 1u);
            const unsigned tg = og / nx;
            if (og + 1u == (tg + 1u) * nx) xb_add(&bar[XB_TOPGEN], 1u);
            else XB_SPIN(xb_ld(&bar[XB_TOPGEN]) == tg, bar);
            __builtin_amdgcn_fence(__ATOMIC_ACQUIRE, "agent");
            xb_add(&bar[XB_XGEN(b.x)], 1u);
            asm volatile("s_waitcnt vmcnt(0)" ::: "memory");
        } else {
            XB_SPIN(xb_ld(&bar[XB_XGEN(b.x)]) == gen, bar);
            __builtin_amdgcn_fence(__ATOMIC_ACQUIRE, "agent");
            asm volatile("s_waitcnt vmcnt(0)" ::: "memory");
        }
    }
    __syncthreads();
}

struct Args { const float* in[22]; float* out; unsigned char* ws; int ph_lo, ph_hi; };
#ifndef PROBE_SP
#define PROBE_SP (-1)
#endif
constexpr int SLOTS = 9 + (PROBE_SP >= 0 ? 1 : 0), N_PHASES = 1 + SLOTS * DEPTH;

__global__ void __launch_bounds__(512, 2) fwd_kernel(Args args) {
    extern __shared__ __attribute__((aligned(16))) unsigned char lds_raw[];
    LAS unsigned char* lds = (LAS unsigned char*)lds_raw;
    cg::grid_group grid = cg::this_grid();
    const int G = gridDim.x, bx = blockIdx.x, NGW = G * 8;
    unsigned char* ws = args.ws;
    unsigned* ctl = (unsigned*)(ws + WS_CTL);
#define tabg   ((float*)(ws + WS_TAB))
#define Win_t  ((bf16_t*)(ws + WS_WIN))
#define Wo3_t  ((bf16_t*)(ws + WS_WO3))
#define Wout_t ((bf16_t*)(ws + WS_WOUT))
#define Wup_t  ((bf16_t*)(ws + WS_WUP))
#define Wdn_t  ((bf16_t*)(ws + WS_WDN))
#define XN     ((bf16_t*)(ws + WS_XN))
#define P      ((bf16_t*)(ws + WS_P))
#define Y      ((bf16_t*)(ws + WS_Y))
#define TMP    ((float*)(ws + WS_TMP))
#define MIX    ((bf16_t*)(ws + WS_MIX))
#define U      ((bf16_t*)(ws + WS_U))
#define ACT    ((bf16_t*)(ws + WS_ACT))
    const float* x_in = args.in[0];
    float* xres = args.out;
    constexpr int I_IN = 32 * (INW / 32), I_O = 8 * 64, I_OUT = 32 * 64, I_UP = 32 * (UPW / 32), I_DN = 88 * 64, I_L = I_IN + 3 * I_O + I_OUT + I_UP + I_DN, I_DEFA = 0;
    const bool defer = false;
#define CONVERT_ITEM(l_, rI_) do { const int l__ = (l_); int r__ = (rI_); LAS float* scr__ = (LAS float*)(lds + wave * 16384); \
        if (r__ < I_IN) { transpose_item(args.in[2] + (size_t)l__ * DM * INW, DM, INW, Win_t + (size_t)l__ * INW * DM, scr__, r__, lane); break; } r__ -= I_IN; \
        if (r__ < 3 * I_O) { const int br__ = r__ / I_O; transpose_item(args.in[10 + br__] + (size_t)l__ * 512 * DM, 512, DM, Wo3_t + (size_t)(l__ * 3 + br__) * DM * 512, scr__, r__ % I_O, lane); break; } r__ -= 3 * I_O; \
        if (r__ < I_OUT) { transpose_item(args.in[13] + (size_t)l__ * DM * DM, DM, DM, Wout_t + (size_t)l__ * DM * DM, scr__, r__, lane); break; } r__ -= I_OUT; \
        if (r__ < I_UP) { transpose_item<true>(args.in[18] + (size_t)l__ * DM * UPW, DM, UPW, Wup_t + (size_t)l__ * UPW * DM, scr__, r__, lane); break; } r__ -= I_UP; \
        transpose_item(args.in[21] + (size_t)l__ * DFF * DM, DFF, DM, Wdn_t + (size_t)l__ * DM * DFF, scr__, r__, lane); } while (0)
    const bool fusedln = (G == 256);
    for (int u = threadIdx.x; u < (LDS_BYTES - 131072) / 4; u += 512) ((LAS unsigned*)(lds + 131072))[u] = 0u;
    __syncthreads();
    XcdBarrier xbar; xbar.bar = ctl + CW_BAR; xbar.x = 0; xbar.st = nullptr;
    if (args.ph_hi - args.ph_lo > 1) xbar = xcd_barrier_post(ctl + CW_BAR, (volatile LAS unsigned*)(lds + 131072 + 320) + 8);
    int nsync = 0;

#if N_LAUNCH_MODE == 1
#pragma clang loop unroll(full)
    for (int ph = 0; ph < N_PHASES; ++ph) {
#else
    for (int ph = args.ph_lo; ph < args.ph_hi; ++ph) {
#endif
      const int q_ = ph > 0 ? (ph - 1) % SLOTS : 0;
      const int l = ph > 0 ? (ph - 1) / SLOTS : 0, sp = (PROBE_SP >= 0 && q_ > PROBE_SP) ? q_ - 1 : q_;
      const int rep = (PROBE_SP >= 0 && q_ == PROBE_SP + 1) ? 1 : 0;
      if (ph > 0 && fusedln && (sp == 4 || sp == 8)) continue;
      {
        if (ph > (N_LAUNCH_MODE == 1 ? 0 : args.ph_lo)) { if (nsync == 0 || !USE_XCD_BAR) grid.sync(); else xcd_barrier(xbar); ++nsync; }
        int tid = threadIdx.x; asm volatile("" : "+v"(tid));
        const int lane = tid & 63, wave = __builtin_amdgcn_readfirstlane(tid >> 6), gw = bx * 8 + wave;
        if (ph == 0) {
#if PH_MASK & 1
            if (bx == 0) {
                for (int idx = tid; idx < 20 * 129; idx += 512) { const int hh = idx / 129, d = idx % 129; int bkt;
                    if (d < 16) bkt = d; else { bkt = 16 + (int)(logf((float)d / 16.f) / 2.0794415416798357f * 16.f); bkt = bkt > 31 ? 31 : bkt; }
                    tabg[hh * TABN + d] = args.in[1][bkt * 20 + hh] * LOG2E; }
            }
            for (int it = gw; it < DEPTH * I_L; it += NGW) {
                const int l = it / I_L, rI = it % I_L;
                if (defer && l > 0 && ((rI >= I_IN && rI < I_IN + I_DEFA) || rI >= I_L - I_DN)) continue;
                CONVERT_ITEM(l, rI);
            }
            row_phase(gw, NGW, lane, x_in, nullptr, nullptr, args.in[14], nullptr, XN);
#endif
            continue;
        }
        if (0) {}
#if PH_MASK & 2
        else if (sp == 0) {
            pg8::Gemm g{XN, Win_t + (size_t)l * INW * DM, DM, DM, DM, 0, 0}; pg8::StaticOrder S; S.init(M, INW, G, bx);
            pg8::EpiProj E{P, args.in[3] + (size_t)l * 3 * DM};
            pg8::gemm_phase<pg8::EpiProj, pg8::StaticOrder, true>(tid, lds, g, S, E);
        }
#endif
#if PH_MASK & 4
        else if (sp == 1) {
            AttnCtx C; C.Pp = P; C.Yp = Y; C.tabp = tabg; C.lq1 = args.in[4] + l * 64; C.lk1 = args.in[5] + l * 64; C.lq2 = args.in[6] + l * 64; C.lk2 = args.in[7] + l * 64;
            C.subg = args.in[8] + l * 128; C.sinks = args.in[9] + l * 8; C.lam_init = 0.8f - 0.6f * __expf(-0.3f * (float)l);
            attn_phase(tid, lds, C, ctl + 64 * (1 + l + 8 * rep), rep ? DUP_KIND : 7);
        }
#endif
#if PH_MASK & 8
        else if (sp == 2) {
            pg8::Gemm g{Y, Wo3_t + (size_t)l * 3 * DM * 512, YW, 512, 512, 512, (long)DM * 512}; pg8::BranchOrder S; S.init(M, DM, G, bx);
            pg8::EpiBranch E{P, MIX};
            pg8::gemm_phase<pg8::EpiBranch, pg8::BranchOrder, true>(tid, lds, g, S, E);
        }
#endif
#if PH_MASK & 16
        else if (sp == 3 || sp == 7) {
            pg8::Gemm g = (sp == 3) ? pg8::Gemm{MIX, Wout_t + (size_t)l * DM * DM, DM, DM, DM, 0, 0} : pg8::Gemm{ACT, Wdn_t + (size_t)l * DM * DFF, DFF, DFF, DFF, 0, 0};
            pg8::StaticOrder S; S.init(M, DM, G, bx);
            if (fusedln) {
                const int k = l * 4 + (sp == 3 ? 0 : 2); float* xb = (float*)(ws + WS_XB);
                const pg8::RowStats s1{xb + (size_t)k * M * 8, ctl + CW_SEAM + k * 2048}, s2{xb + (size_t)(k + 1) * M * 8, ctl + CW_SEAM + (k + 1) * 2048};
                const bool more = (sp == 3) || (l + 1 < DEPTH);
                pg8::EpiNormRes E{(sp == 3 && l == 0) ? x_in : xres, xres, more ? XN : nullptr, (sp == 3 ? args.in[15] : args.in[17]) + l * DM,
                                  sp == 3 ? args.in[16] + l * DM : args.in[14] + (l + 1 < DEPTH ? l + 1 : 0) * DM, s1, s2};
                pg8::gemm_phase<pg8::EpiNormRes, pg8::StaticOrder, false>(tid, lds, g, S, E);
            } else {
                pg8::EpiF32 E{TMP};
                pg8::gemm_phase<pg8::EpiF32, pg8::StaticOrder, true>(tid, lds, g, S, E);
            }
        }
#endif
#if PH_MASK & 32
        else if (sp == 4) {
            row_phase(gw, NGW, lane, l == 0 ? x_in : xres, TMP, args.in[15] + l * DM, args.in[16] + l * DM, xres, XN);
        }
#endif
#if PH_MASK & 64
        else if (sp == 5) {
            pg8::Gemm g{XN, Wup_t + (size_t)l * UPW * DM, DM, DM, DM, 0, 0}; pg8::StaticOrder S; S.init(M, UPW, G, bx, 5);
            pg8::EpiUpConv E{ACT, (float*)U, args.in[19] + (size_t)l * 3 * UPW, args.in[20] + (size_t)l * UPW};
            pg8::gemm_phase<pg8::EpiUpConv, pg8::StaticOrder, true>(tid, lds, g, S, E);
            { pg8::HalfTailOrder S2; S2.init(M, UPW, G, bx);
              pg8::EpiUpConvHalf E2{E};
              pg8::gemm_phase<pg8::EpiUpConvHalf, pg8::HalfTailOrder, true, true>(tid, lds, g, S2, E2); }
            if (defer && l + 1 < DEPTH && bx >= 128) {
                for (int k = (bx - 128) * 8 + wave; k < I_DEFA + I_DN; k += 128 * 8) CONVERT_ITEM(l + 1, k < I_DEFA ? I_IN + k : I_L - I_DN + (k - I_DEFA));
            }
        }
#endif
#if PH_MASK & 128
        else if (sp == 6) {
            conv_fix_phase(bx * 512 + tid, G * 512, (const float*)U, args.in[19] + (size_t)l * 3 * UPW, args.in[20] + (size_t)l * UPW, ACT);
        }
#endif
#if PH_MASK & 256
        else {
            row_phase(gw, NGW, lane, xres, TMP, args.in[17] + l * DM, l + 1 < DEPTH ? args.in[14] + (l + 1) * DM : nullptr, xres, l + 1 < DEPTH ? XN : nullptr);
        }
#endif
      }
    }
}

#undef tabg
#undef Win_t
#undef Wo3_t
#undef Wout_t
#undef Wup_t
#undef Wdn_t
#undef XN
#undef P
#undef Y
#undef TMP
#undef MIX
#undef U
#undef ACT
extern "C" void kernel_launch(void* const* d_in, const int* in_sizes, int n_in, void* d_out, int out_size, void* d_ws, size_t ws_size, hipStream_t stream) {
    static int grid = 0;
    if (grid == 0) {
        if (n_in != 22 || out_size != M * DM || ws_size < WS_END) { fprintf(stderr, "kernel_launch: unexpected problem (n_in %d out %d ws %zu)\n", n_in, out_size, ws_size); grid = -1; return; }
        int dev = 0, cus = 0, per_cu = 0;
        hipGetDevice(&dev); hipDeviceGetAttribute(&cus, hipDeviceAttributeMultiprocessorCount, dev);
        hipFuncSetAttribute((const void*)fwd_kernel, hipFuncAttributeMaxDynamicSharedMemorySize, LDS_BYTES);
        hipOccupancyMaxActiveBlocksPerMultiprocessor(&per_cu, (const void*)fwd_kernel, 512, LDS_BYTES);
        (void)hipGetLastError();
        if (per_cu < 1) { fprintf(stderr, "kernel_launch: occupancy query says %d blocks per CU\n", per_cu); per_cu = 1; }
        grid = cus;
        fprintf(stderr, "kernel_launch: grid %d (per_cu %d)\n", grid, per_cu);
    }
    if (grid < 0) return;
    hipMemsetAsync((char*)d_ws + WS_CTL, 0, CTL_ZERO_BYTES, stream);
    Args a{};
    for (int i = 0; i < 22; ++i) a.in[i] = (const float*)d_in[i];
    a.out = (float*)d_out; a.ws = (unsigned char*)d_ws;
#if N_LAUNCH_MODE == 1
    a.ph_lo = 0; a.ph_hi = N_PHASES;
    void* kargs[] = {&a};
    hipError_t e = hipLaunchCooperativeKernel((const void*)fwd_kernel, dim3(grid), dim3(512), kargs, LDS_BYTES, stream);
    if (e != hipSuccess) fprintf(stderr, "cooperative launch failed: %s (grid %d)\n", hipGetErrorString(e), grid);
#else
    for (int ph = 0; ph < N_PHASES; ++ph) { a.ph_lo = ph; a.ph_hi = ph + 1; hipLaunchKernelGGL(fwd_kernel, dim3(grid), dim3(512), LDS_BYTES, stream, a); }
#endif
}
```

```cpp
#include <hip/hip_runtime.h>
#include <hip/hip_cooperative_groups.h>
#include <cstdio>
#include <cstdint>
namespace cg = cooperative_groups;

#ifndef PH_MASK
#define PH_MASK 511
#endif
#ifndef ATTN_INL
#define ATTN_INL __device__ __forceinline__
#endif
#ifndef KIND_MASK
#define KIND_MASK 7
#endif
#ifndef USE_XCD_BAR
#define USE_XCD_BAR 1
#endif
#ifndef DUP_KIND
#define DUP_KIND 7
#endif
#ifndef N_LAUNCH_MODE
#define N_LAUNCH_MODE 1
#endif

#define DI __device__ __forceinline__
#define LAS __attribute__((address_space(3)))
typedef unsigned short bf16_t;
typedef short bf16x8 __attribute__((ext_vector_type(8)));
typedef short s16x4 __attribute__((ext_vector_type(4)));
typedef float f32x4 __attribute__((ext_vector_type(4)));
typedef float f32x2 __attribute__((ext_vector_type(2)));
typedef float f32x16 __attribute__((ext_vector_type(16)));
typedef unsigned u32x4 __attribute__((ext_vector_type(4)));
typedef unsigned u32x2 __attribute__((ext_vector_type(2)));
typedef __bf16 bf16x2n __attribute__((ext_vector_type(2)));

constexpr int DM = 2048, NB = 4, SEQ = 2048, DEPTH = 4, M = NB * SEQ;
constexpr int INW = 9984, DFF = 5632, UPW = 11264, YW = 1536;
constexpr int C_QA = 0, C_KA = 512, C_VA = 1024, C_QB = 1536, C_KB = 2048, C_VB = 2176, C_QC = 2304, C_KC = 2816, C_VC = 3328, C_G = 3840;
constexpr float EPS = 1e-6f;
constexpr float LOG2E = 1.4426950408889634f;
constexpr float SC2 = 0.125f * LOG2E;
constexpr int TABN = 132;

constexpr size_t MiB = 1u << 20;
constexpr size_t WS_CTL = 0, CTL_ZERO_BYTES = 1 * MiB;
constexpr size_t WS_TAB = 1 * MiB;
constexpr size_t WS_WIN = 2 * MiB, WS_WO3 = 158 * MiB, WS_WOUT = 182 * MiB, WS_WUP = 214 * MiB, WS_WDN = 390 * MiB;
constexpr size_t WS_XN = 478 * MiB, WS_P = 510 * MiB, WS_Y = 666 * MiB, WS_TMP = 690 * MiB, WS_MIX = 754 * MiB, WS_U = 786 * MiB, WS_ACT = 962 * MiB, WS_XB = 1050 * MiB, WS_END = 1054 * MiB;
constexpr int CW_SEAM = 16384;
constexpr int LDS_BYTES = 147456;

DI unsigned pk2(float lo, float hi) { f32x2 v = {lo, hi}; return __builtin_bit_cast(unsigned, __builtin_convertvector(v, bf16x2n)); }
DI float bflo(unsigned w) { return __uint_as_float(w << 16); }
DI float bfhi(unsigned w) { return __uint_as_float(w & 0xffff0000u); }
DI float wave_sum(float v) {
#pragma unroll
    for (int o = 1; o < 64; o <<= 1) v += __shfl_xor(v, o);
    return v;
}
DI float fexp2(float x) { return __builtin_amdgcn_exp2f(x); }
DI float frcp(float x) { return __builtin_amdgcn_rcpf(x); }

namespace pg8 {
constexpr int BM = 256, BK = 64, HALF = 128, HTB = HALF * BK * 2, STAGE_BYTES = 8 * HTB, NXCD = 8, WGM = 8;
DI int lds_byte(int r, int c) { const int st = (r >> 4) * 2 + (c >> 5), rr = r & 15, cc = c & 31, ob = rr * 64 + cc * 2; return st * 1024 + (ob ^ (((ob >> 9) & 1) << 5)); }
DI void stage_rc(int b, int& R, int& C) { const int st = b / 1024, sb = b % 1024, swz = sb ^ (((sb >> 9) & 1) << 5); R = (st >> 1) * 16 + swz / 64; C = (st & 1) * 32 + (swz % 64) / 2; }
DI int perm32(int rho) { const int n = rho >> 4, i = rho & 15; return 8 * (i >> 2) + 4 * n + (i & 3); }

struct Unit { int pm, pn, z; };
struct Gemm { const bf16_t* A; const bf16_t* Bt; int lda, ldb, K; long zA, zB; };

DI void tile_of(int wgid, int nM, int nN, Unit& u) {
    const int nwg = nM * nN;
    { const int q = nwg / NXCD, r = nwg % NXCD, xcd = wgid % NXCD, off = wgid / NXCD; wgid = (xcd < r ? xcd * (q + 1) : r * (q + 1) + (xcd - r) * q) + off; }
    const int nig = WGM * nN, gid = wgid / nig, fm = gid * WGM, gsz = (nM - fm) < WGM ? (nM - fm) : WGM;
    u.pm = fm + ((wgid % nig) % gsz); u.pn = (wgid % nig) / gsz;
}
struct StaticOrder {
    int nM, nN, nwg, G, c;
    DI void init(int M_, int N_, int G_, int c_) { nM = M_ / BM; nN = N_ / BM; nwg = nM * nN; G = G_; c = c_; }
    DI bool next(int i, Unit& u) const {
        const long L = (long)i * G + c; if (L >= nwg) return false;
        tile_of((int)L, nM, nN, u); u.z = 0; return true;
    }
};
struct BranchOrder {
    int nM, nN, nwg, G, c;
    DI void init(int M_, int N_, int G_, int c_) { nM = M_ / BM; nN = N_ / BM; nwg = nM * nN; G = G_; c = c_; }
    DI bool next(int i, Unit& u) const {
        const long L = (long)(i / 3) * G + c; if (L >= nwg) return false;
        tile_of((int)L, nM, nN, u); u.z = i % 3; return true;
    }
};

typedef f32x4 Acc[2][2][4][2];

template <class Epi, class Sched, bool ALIGN_EPI>
DI void gemm_phase(int tid, LAS unsigned char* lds, const Gemm g, const Sched& S, const Epi& E) {
    const int wid = __builtin_amdgcn_readfirstlane(tid >> 6), lane = tid & 63, wr = wid >> 2, wc = wid & 3, fr = lane & 15, fq = lane >> 4;
    const int K = g.K, nt = K / BK;
    unsigned voffA[2], voffB[2];
#pragma unroll
    for (int i = 0; i < 2; ++i) { int R, C; stage_rc(tid * 16 + i * 8192, R, C); const int Rb = Epi::PERM ? ((R & ~31) + perm32(R & 31)) : R;
        voffA[i] = (unsigned)(R * g.lda + C) * 2u; voffB[i] = (unsigned)(Rb * g.ldb + C) * 2u; }
    const size_t kstep = (size_t)(BK * 2);
    const size_t hA = (size_t)HALF * g.lda * 2, hB = (size_t)HALF * g.ldb * 2, tA = 2 * hA, tB = 2 * hB;
    const unsigned ldsw = (unsigned)wid * 1024u;
    const int aoff = lds_byte(wr * 64 + fr, fq * 8), boff = lds_byte(wc * 32 + fr, fq * 8);
#define PG8_SA(b, h) (((b) * 2 + (h)) * HTB)
#define PG8_SB(b, h) ((4 + (b) * 2 + (h)) * HTB)
#define PG8_STAGE(bufoff, gbase, voff) do { _Pragma("unroll") for (int _i = 0; _i < 2; ++_i) \
        __builtin_amdgcn_global_load_lds((const unsigned*)((const char*)(gbase) + (voff)[_i]), (LAS unsigned*)(lds + (bufoff) + ldsw + _i * 8192), 16, 0, 0); } while (0)
#define PG8_LDA(dst, b, h) do { _Pragma("unroll") for (int m = 0; m < 4; ++m) _Pragma("unroll") for (int k = 0; k < 2; ++k) dst[m][k] = *(const LAS bf16x8*)(lds + PG8_SA(b, h) + aoff + m * 2048 + k * 1024); } while (0)
#define PG8_LDB(dst, b, h) do { _Pragma("unroll") for (int n = 0; n < 2; ++n) _Pragma("unroll") for (int k = 0; k < 2; ++k) dst[n][k] = *(const LAS bf16x8*)(lds + PG8_SB(b, h) + boff + n * 2048 + k * 1024); } while (0)
#define PG8_MMA(ai, bj, At, Bt) do { __builtin_amdgcn_s_setprio(1); _Pragma("unroll") for (int m = 0; m < 4; ++m) _Pragma("unroll") for (int n = 0; n < 2; ++n) _Pragma("unroll") for (int k = 0; k < 2; ++k) \
        acc[ai][bj][m][n] = __builtin_amdgcn_mfma_f32_16x16x32_bf16(Bt[n][k], At[m][k], acc[ai][bj][m][n], 0, 0, 0); __builtin_amdgcn_s_setprio(0); } while (0)
#define PG8_WAIT_V(n) asm volatile("s_waitcnt vmcnt(" #n ")" ::: "memory")
#define PG8_WAIT_L(n) asm volatile("s_waitcnt lgkmcnt(" #n ")" ::: "memory")
#define PG8_BAR __builtin_amdgcn_s_barrier()
#define PG8_SCHED __builtin_amdgcn_sched_barrier(0)
    Unit cur, nxt; int ui = 0;
    if (!S.next(0, cur)) return;
    Acc acc;
#pragma unroll
    for (int a = 0; a < 2; ++a)
#pragma unroll
        for (int b = 0; b < 2; ++b)
#pragma unroll
            for (int m = 0; m < 4; ++m)
#pragma unroll
                for (int n = 0; n < 2; ++n) acc[a][b][m][n] = (f32x4){0.f, 0.f, 0.f, 0.f};
    bf16x8 At[4][2], B0[2][2], B1[2][2];
    const char* cA = (const char*)(g.A + (size_t)cur.z * g.zA) + (size_t)cur.pm * tA; const char* cB = (const char*)(g.Bt + (size_t)cur.z * g.zB) + (size_t)cur.pn * tB;
    PG8_STAGE(PG8_SB(0, 0), cB, voffB); PG8_STAGE(PG8_SB(0, 1), cB + hB, voffB); PG8_STAGE(PG8_SA(0, 0), cA, voffA); PG8_STAGE(PG8_SA(0, 1), cA + hA, voffA);
    if (wr == 1) PG8_BAR;
    PG8_WAIT_V(2); PG8_BAR;
    PG8_STAGE(PG8_SB(1, 0), cB + kstep, voffB); PG8_STAGE(PG8_SA(1, 0), cA + kstep, voffA); PG8_STAGE(PG8_SB(1, 1), cB + hB + kstep, voffB);
    PG8_WAIT_V(6); PG8_BAR;
    for (;;) {
        const bool has_next = S.next(ui + 1, nxt);
        const char* nA = has_next ? (const char*)(g.A + (size_t)nxt.z * g.zA) + (size_t)nxt.pm * tA : cA; const char* nB = has_next ? (const char*)(g.Bt + (size_t)nxt.z * g.zB) + (size_t)nxt.pn * tB : cB;
        for (int t = 0; t < nt; t += 2) {
            const bool last = (t == nt - 2);
            const char* a1 = cA + (size_t)(t + 1) * kstep;
            const char* a2 = last ? nA : cA + (size_t)(t + 2) * kstep; const char* b2 = last ? nB : cB + (size_t)(t + 2) * kstep;
            const char* a3 = a2 + kstep; const char* b3 = b2 + kstep;
            PG8_LDB(B0, 0, 0); PG8_LDB(B1, 0, 1); PG8_SCHED; PG8_LDA(At, 0, 0); PG8_STAGE(PG8_SA(1, 1), a1 + hA, voffA);
            PG8_WAIT_V(8); PG8_WAIT_L(0); PG8_BAR; PG8_MMA(0, 0, At, B0); PG8_MMA(0, 1, At, B1); PG8_BAR; PG8_SCHED;
            PG8_LDA(At, 0, 1); PG8_STAGE(PG8_SB(0, 0), b2, voffB); PG8_STAGE(PG8_SB(0, 1), b2 + hB, voffB); PG8_STAGE(PG8_SA(0, 0), a2, voffA);
            PG8_WAIT_V(8); PG8_WAIT_L(0); PG8_BAR; PG8_MMA(1, 0, At, B0); PG8_MMA(1, 1, At, B1); PG8_BAR; PG8_SCHED;
            PG8_LDB(B0, 1, 0); PG8_LDB(B1, 1, 1); PG8_SCHED; PG8_LDA(At, 1, 0); PG8_STAGE(PG8_SA(0, 1), a2 + hA, voffA);
            PG8_WAIT_V(8); PG8_WAIT_L(0); PG8_BAR; PG8_MMA(0, 0, At, B0); PG8_MMA(0, 1, At, B1); PG8_BAR; PG8_SCHED;
            PG8_LDA(At, 1, 1); PG8_STAGE(PG8_SB(1, 0), b3, voffB); PG8_STAGE(PG8_SB(1, 1), b3 + hB, voffB); PG8_STAGE(PG8_SA(1, 0), a3, voffA);
            PG8_WAIT_V(8); PG8_WAIT_L(0); PG8_BAR; PG8_MMA(1, 0, At, B0); PG8_MMA(1, 1, At, B1); PG8_BAR; PG8_SCHED;
        }
        if constexpr (ALIGN_EPI) { if (wr == 0) PG8_BAR; }
        if constexpr (!Epi::AFTER_DRAIN) E(acc, cur, wr, wc, fr, fq);
        if (!has_next) break;
        if (!(Epi::KEEP_ACC && nxt.z != 0))
#pragma unroll
        for (int a = 0; a < 2; ++a)
#pragma unroll
            for (int b = 0; b < 2; ++b)
#pragma unroll
                for (int m = 0; m < 4; ++m)
#pragma unroll
                    for (int n = 0; n < 2; ++n) acc[a][b][m][n] = (f32x4){0.f, 0.f, 0.f, 0.f};
        cur = nxt; cA = nA; cB = nB; ++ui;
        if constexpr (ALIGN_EPI) { if (wr == 1) PG8_BAR; }
    }
    PG8_WAIT_V(0);
    if constexpr (!ALIGN_EPI) { if (wr == 0) PG8_BAR; }
    PG8_BAR;
    if constexpr (Epi::AFTER_DRAIN) E.fused(acc, cur, wr, wc, fr, fq, lds, wid, lane);
#undef PG8_SA
#undef PG8_SB
#undef PG8_STAGE
#undef PG8_LDA
#undef PG8_LDB
#undef PG8_MMA
#undef PG8_WAIT_V
#undef PG8_WAIT_L
#undef PG8_BAR
#undef PG8_SCHED
}

struct EpiProj {
    static constexpr bool PERM = true, AFTER_DRAIN = false, KEEP_ACC = false;
    bf16_t* O; const float* bgate;
    DI void operator()(const Acc& acc, const Unit& u, int wr, int wc, int fr, int fq) const {
        const int row0 = u.pm * BM + wr * 64 + fr, col0 = u.pn * BM + wc * 32 + 8 * fq;
        const bool gate = u.pn >= (C_G / 256);
        f32x4 bv[2][2];
#pragma unroll
        for (int bj = 0; bj < 2; ++bj)
#pragma unroll
            for (int n = 0; n < 2; ++n) bv[bj][n] = gate ? *(const f32x4*)(bgate + (col0 - C_G) + bj * HALF + 4 * n) : (f32x4){0.f, 0.f, 0.f, 0.f};
#pragma unroll
        for (int ai = 0; ai < 2; ++ai)
#pragma unroll
            for (int m = 0; m < 4; ++m) { bf16_t* rowp = O + (size_t)(row0 + ai * HALF + m * 16) * INW + col0;
#pragma unroll
                for (int bj = 0; bj < 2; ++bj) { f32x4 v0 = acc[ai][bj][m][0] + bv[bj][0], v1 = acc[ai][bj][m][1] + bv[bj][1];
                    if (gate) {
#pragma unroll
                        for (int e = 0; e < 4; ++e) { v0[e] = frcp(1.f + fexp2(-v0[e] * LOG2E)); v1[e] = frcp(1.f + fexp2(-v1[e] * LOG2E)); } }
                    u32x4 w; w.x = pk2(v0[0], v0[1]); w.y = pk2(v0[2], v0[3]); w.z = pk2(v1[0], v1[1]); w.w = pk2(v1[2], v1[3]);
                    *(u32x4*)(rowp + bj * HALF) = w; } }
    }
};
struct EpiBf16 {
    static constexpr bool PERM = true, AFTER_DRAIN = false, KEEP_ACC = false;
    bf16_t* O; int ldc;
    DI void operator()(const Acc& acc, const Unit& u, int wr, int wc, int fr, int fq) const {
        const int row0 = u.pm * BM + wr * 64 + fr, col0 = u.pn * BM + wc * 32 + 8 * fq;
#pragma unroll
        for (int ai = 0; ai < 2; ++ai)
#pragma unroll
            for (int m = 0; m < 4; ++m) { bf16_t* rowp = O + (size_t)(row0 + ai * HALF + m * 16) * ldc + col0;
#pragma unroll
                for (int bj = 0; bj < 2; ++bj) { const f32x4 v0 = acc[ai][bj][m][0], v1 = acc[ai][bj][m][1];
                    u32x4 w; w.x = pk2(v0[0], v0[1]); w.y = pk2(v0[2], v0[3]); w.z = pk2(v1[0], v1[1]); w.w = pk2(v1[2], v1[3]);
                    *(u32x4*)(rowp + bj * HALF) = w; } }
    }
};
struct EpiF32 {
    static constexpr bool PERM = false, AFTER_DRAIN = false, KEEP_ACC = false;
    float* O;
    DI void operator()(const Acc& acc, const Unit& u, int wr, int wc, int fr, int fq) const {
        const int row0 = u.pm * BM + wr * 64 + fr, col0 = u.pn * BM + wc * 32 + 4 * fq;
#pragma unroll
        for (int ai = 0; ai < 2; ++ai)
#pragma unroll
            for (int m = 0; m < 4; ++m) { float* rowp = O + (size_t)(row0 + ai * HALF + m * 16) * DM + col0;
#pragma unroll
                for (int bj = 0; bj < 2; ++bj)
#pragma unroll
                    for (int n = 0; n < 2; ++n) *(f32x4*)(rowp + bj * HALF + n * 16) = acc[ai][bj][m][n]; }
    }
};
DI float dpp_shr1(float oldv, float src) { return __builtin_bit_cast(float, __builtin_amdgcn_update_dpp(__builtin_bit_cast(int, oldv), __builtin_bit_cast(int, src), 0x111, 0xf, 0xf, false)); }
DI float dpp_shr2(float oldv, float src) { return __builtin_bit_cast(float, __builtin_amdgcn_update_dpp(__builtin_bit_cast(int, oldv), __builtin_bit_cast(int, src), 0x112, 0xf, 0xf, false)); }
DI float dpp_ror1(float src) { return __builtin_bit_cast(float, __builtin_amdgcn_update_dpp(0, __builtin_bit_cast(int, src), 0x121, 0xf, 0xf, false)); }
DI float dpp_ror2(float src) { return __builtin_bit_cast(float, __builtin_amdgcn_update_dpp(0, __builtin_bit_cast(int, src), 0x122, 0xf, 0xf, false)); }
DI float gelu_t(float x) { const float z = 1.5957691216057308f * (x + 0.044715f * x * x * x); return x * frcp(1.f + fexp2(-z * LOG2E)); }
struct EpiUpConv {
    static constexpr bool PERM = true, AFTER_DRAIN = false, KEEP_ACC = false;
    bf16_t* ACT; float* RAW; const float* cw; const float* cb;
    DI void operator()(const Acc& acc, const Unit& u, int wr, int wc, int fr, int fq) const {
        const int ch0 = u.pn * HALF + wc * 32 + 8 * fq;
        const int ic0 = u.pn * BM + wc * 32 + 8 * fq;
#pragma unroll
        for (int n = 0; n < 2; ++n) {
            f32x4 wg[3], wv[3], bg, bv;
#pragma unroll
            for (int k = 0; k < 3; ++k) { wg[k] = *(const f32x4*)(cw + k * UPW + ch0 + 4 * n); wv[k] = *(const f32x4*)(cw + k * UPW + DFF + ch0 + 4 * n); }
            bg = *(const f32x4*)(cb + ch0 + 4 * n); bv = *(const f32x4*)(cb + DFF + ch0 + 4 * n);
#pragma unroll
            for (int ai = 0; ai < 2; ++ai) {
                const int gidx = 4 * u.pm + 2 * ai + wr;
                float* rawg = RAW + (size_t)gidx * 4 * UPW + ic0 + 4 * n;
#pragma unroll
                for (int m = 0; m < 4; ++m) {
                    const f32x4 xg = acc[ai][0][m][n], xv = acc[ai][1][m][n];
                    if (m == 0 && fr < 2) { *(f32x4*)(rawg + (size_t)fr * UPW) = xg; *(f32x4*)(rawg + (size_t)fr * UPW + HALF) = xv; }
                    if (m == 3 && fr >= 14) { *(f32x4*)(rawg + (size_t)(fr - 12) * UPW) = xg; *(f32x4*)(rawg + (size_t)(fr - 12) * UPW + HALF) = xv; }
                    float res[4];
#pragma unroll
                    for (int e = 0; e < 4; ++e) {
                        float o1g = 0.f, o2g = 0.f, o1v = 0.f, o2v = 0.f;
                        if (m > 0) { o1g = dpp_ror1(acc[ai][0][m - 1][n][e]); o2g = dpp_ror2(acc[ai][0][m - 1][n][e]); o1v = dpp_ror1(acc[ai][1][m - 1][n][e]); o2v = dpp_ror2(acc[ai][1][m - 1][n][e]); }
                        const float p1g = dpp_shr1(o1g, xg[e]), p2g = dpp_shr2(o2g, xg[e]), p1v = dpp_shr1(o1v, xv[e]), p2v = dpp_shr2(o2v, xv[e]);
                        const float cgv = bg[e] + wg[0][e] * p2g + wg[1][e] * p1g + wg[2][e] * xg[e];
                        const float cvv = bv[e] + wv[0][e] * p2v + wv[1][e] * p1v + wv[2][e] * xv[e];
                        res[e] = gelu_t(cgv) * cvv;
                    }
                    u32x2 w; w.x = pk2(res[0], res[1]); w.y = pk2(res[2], res[3]);
                    *(u32x2*)(ACT + (size_t)(u.pm * BM + ai * HALF + wr * 64 + m * 16 + fr) * DFF + ch0 + 4 * n) = w;
                }
            }
        }
    }
};
struct EpiBranch {
    static constexpr bool PERM = true, AFTER_DRAIN = false, KEEP_ACC = true;
    const bf16_t* P; bf16_t* mix;
    DI void operator()(Acc& acc, const Unit& u, int wr, int wc, int fr, int fq) const {
        const int row0 = u.pm * BM + wr * 64 + fr, col0 = u.pn * BM + wc * 32 + 8 * fq;
#pragma unroll
        for (int ai = 0; ai < 2; ++ai) {
            u32x4 ga[4][2], gb[4][2];
#pragma unroll
            for (int m = 0; m < 4; ++m) { const bf16_t* gp = P + (size_t)(row0 + ai * HALF + m * 16) * INW + C_G + u.z * DM + col0;
#pragma unroll
                for (int bj = 0; bj < 2; ++bj) { ga[m][bj] = *(const u32x4*)(gp + bj * HALF); gb[m][bj] = (u.z < 2) ? *(const u32x4*)(gp + DM + bj * HALF) : ga[m][bj]; } }
#pragma unroll
            for (int m = 0; m < 4; ++m) { const size_t row = (size_t)(row0 + ai * HALF + m * 16);
#pragma unroll
                for (int bj = 0; bj < 2; ++bj) {
                    float g[8];
#pragma unroll
                    for (int e = 0; e < 4; ++e) { g[2 * e] = fmaxf(bflo(ga[m][bj][e]), 1e-6f); g[2 * e + 1] = fmaxf(bfhi(ga[m][bj][e]), 1e-6f); }
                    if (u.z < 2) {
#pragma unroll
                        for (int e = 0; e < 4; ++e) { g[2 * e] *= frcp(fmaxf(bflo(gb[m][bj][e]), 1e-6f)); g[2 * e + 1] *= frcp(fmaxf(bfhi(gb[m][bj][e]), 1e-6f)); }
#pragma unroll
                        for (int e = 0; e < 4; ++e) { acc[ai][bj][m][0][e] *= g[e]; acc[ai][bj][m][1][e] *= g[4 + e]; }
                    } else {
                        const f32x4 v0 = acc[ai][bj][m][0], v1 = acc[ai][bj][m][1];
                        u32x4 w; w.x = pk2(v0[0] * g[0], v0[1] * g[1]); w.y = pk2(v0[2] * g[2], v0[3] * g[3]); w.z = pk2(v1[0] * g[4], v1[1] * g[5]); w.w = pk2(v1[2] * g[6], v1[3] * g[7]);
                        *(u32x4*)(mix + row * DM + col0 + bj * HALF) = w;
                    }
                } }
        }
    }
};
struct RowStats {
    float* xbuf;
    unsigned* cnt;
    DI void run(const Acc& v, const Unit& u, int wr, int wc, int fr, int fq, LAS unsigned char* lds, int wid, int lane) const {
        LAS float* Pp = (LAS float*)lds;
        LAS float* S = (LAS float*)(lds + 4096);
#pragma unroll
        for (int ai = 0; ai < 2; ++ai)
#pragma unroll
            for (int m = 0; m < 4; ++m) {
                float q = 0.f;
#pragma unroll
                for (int bj = 0; bj < 2; ++bj)
#pragma unroll
                    for (int n = 0; n < 2; ++n) { const f32x4 x = v[ai][bj][m][n]; q += (x[0] * x[0] + x[1] * x[1]) + (x[2] * x[2] + x[3] * x[3]); }
                q += __shfl_xor(q, 16); q += __shfl_xor(q, 32);
                if (fq == 0) Pp[(ai * HALF + wr * 64 + m * 16 + fr) * 4 + wc] = q;
            }
        asm volatile("s_waitcnt lgkmcnt(0)" ::: "memory"); __builtin_amdgcn_s_barrier(); asm volatile("" ::: "memory");
        const int row = wid * 32 + (lane & 31);
        if (lane < 32) {
            const float t = (Pp[row * 4 + 0] + Pp[row * 4 + 1]) + (Pp[row * 4 + 2] + Pp[row * 4 + 3]);
            __hip_atomic_store(xbuf + (size_t)(u.pm * BM + row) * 8 + u.pn, t, __ATOMIC_RELAXED, __HIP_MEMORY_SCOPE_AGENT);
        }
        asm volatile("s_waitcnt vmcnt(0)" ::: "memory");
        if (lane == 0) __hip_atomic_fetch_add(cnt + 64 * u.pm, 1u, __ATOMIC_RELAXED, __HIP_MEMORY_SCOPE_AGENT);
        if (wid == 0) {
            unsigned spin = 0;
            while ((unsigned)__builtin_amdgcn_readfirstlane(__hip_atomic_load(cnt + 64 * u.pm, __ATOMIC_RELAXED, __HIP_MEMORY_SCOPE_AGENT)) < 64u) { __builtin_amdgcn_s_sleep(1); if (++spin > (1u << 22)) break; }
        }
        asm volatile("s_waitcnt vmcnt(0) lgkmcnt(0)" ::: "memory"); __builtin_amdgcn_s_barrier(); asm volatile("" ::: "memory");
        if (lane < 32) {
            const float* slot = xbuf + (size_t)(u.pm * BM + row) * 8; float t = 0.f;
#pragma unroll
            for (int k = 0; k < 8; ++k) t += __hip_atomic_load(slot + k, __ATOMIC_RELAXED, __HIP_MEMORY_SCOPE_AGENT);
            S[row] = rsqrtf(t * (1.f / DM) + EPS);
        }
        asm volatile("s_waitcnt lgkmcnt(0)" ::: "memory"); __builtin_amdgcn_s_barrier(); asm volatile("" ::: "memory");
    }
};
struct EpiNormRes {
    static constexpr bool PERM = false, AFTER_DRAIN = true, KEEP_ACC = false;
    const float* xin; float* xout; bf16_t* xn; const float* gpost; const float* gpre; RowStats st1, st2;
    DI void operator()(const Acc&, const Unit&, int, int, int, int) const {}
    DI void fused(Acc& acc, const Unit& u, int wr, int wc, int fr, int fq, LAS unsigned char* lds, int wid, int lane) const {
        const LAS float* S = (const LAS float*)(lds + 4096);
        const int col0 = u.pn * BM + wc * 32 + 4 * fq;
        f32x4 pre[4][2][2];
        LAS float* GL = (LAS float*)(lds + 8192);
        { const int t = wid * 64 + lane; if (t < 64) *(LAS f32x4*)(GL + 4 * t) = *(const f32x4*)(gpost + u.pn * BM + 4 * t); else if (t < 128 && xn) *(LAS f32x4*)(GL + 4 * t) = *(const f32x4*)(gpre + u.pn * BM + 4 * (t - 64)); }
        const int lc0 = wc * 32 + 4 * fq;
#pragma unroll
        for (int m = 0; m < 4; ++m) { const size_t off = (size_t)(u.pm * BM + wr * 64 + m * 16 + fr) * DM + col0;
#pragma unroll
            for (int bj = 0; bj < 2; ++bj)
#pragma unroll
                for (int n = 0; n < 2; ++n) pre[m][bj][n] = *(const f32x4*)(xin + off + bj * HALF + n * 16); }
        st1.run(acc, u, wr, wc, fr, fq, lds, wid, lane);
#pragma unroll
        for (int ai = 0; ai < 2; ++ai) {
            if (ai == 1) {
#pragma unroll
                for (int m = 0; m < 4; ++m) { const size_t off = (size_t)(u.pm * BM + HALF + wr * 64 + m * 16 + fr) * DM + col0;
#pragma unroll
                    for (int bj = 0; bj < 2; ++bj)
#pragma unroll
                        for (int n = 0; n < 2; ++n) pre[m][bj][n] = *(const f32x4*)(xin + off + bj * HALF + n * 16); }
            }
#pragma unroll
            for (int m = 0; m < 4; ++m) { const int r = ai * HALF + wr * 64 + m * 16 + fr; const float rs = S[r]; const size_t off = (size_t)(u.pm * BM + r) * DM + col0;
                const LAS float* gl = GL + lc0; asm volatile("" : "+v"(gl));
#pragma unroll
                for (int bj = 0; bj < 2; ++bj)
#pragma unroll
                    for (int n = 0; n < 2; ++n) { const f32x4 gv = *(const LAS f32x4*)(gl + bj * HALF + n * 16); const f32x4 o = pre[m][bj][n] + acc[ai][bj][m][n] * rs * gv; acc[ai][bj][m][n] = o; *(f32x4*)(xout + off + bj * HALF + n * 16) = o; } }
        }
        if (xn) {
            st2.run(acc, u, wr, wc, fr, fq, lds, wid, lane);
#pragma unroll
            for (int ai = 0; ai < 2; ++ai)
#pragma unroll
                for (int m = 0; m < 4; ++m) { const int r = ai * HALF + wr * 64 + m * 16 + fr; const float rs = S[r]; const size_t off = (size_t)(u.pm * BM + r) * DM + col0;
                    const LAS float* gl = GL + 256 + lc0; asm volatile("" : "+v"(gl));
#pragma unroll
                    for (int bj = 0; bj < 2; ++bj)
#pragma unroll
                        for (int n = 0; n < 2; ++n) { const f32x4 gv = *(const LAS f32x4*)(gl + bj * HALF + n * 16); const f32x4 o = acc[ai][bj][m][n] * rs * gv;
                            u32x2 w; w.x = pk2(o[0], o[1]); w.y = pk2(o[2], o[3]); *(u32x2*)(xn + off + bj * HALF + n * 16) = w; } }
        }
    }
};
}

constexpr int KP = 144, VP = 136;
constexpr int AT_EXT = 107520, AT_SEL = 74752, AT_KM = 75776, AT_PARTS = 77824, AT_MISC = 106496;
DI f32x16 mfma32(bf16x8 a, bf16x8 b, f32x16 c) { return __builtin_amdgcn_mfma_f32_32x32x16_bf16(a, b, c, 0, 0, 0); }

template <int DV>
DI void wave_tile(const LAS unsigned char* Kl, const LAS unsigned char* Vl, const LAS float* tbp, const bf16x8 (&qf)[4], f32x16 (&o)[DV / 32], float& m, float& l,
                  int r, int h, bool near, float cadd) {
    f32x16 s[2];
    {
        f32x16 a0, a1;
#pragma unroll
        for (int i = 0; i < 16; ++i) { a0[i] = 0.f; a1[i] = 0.f; }
#pragma unroll
        for (int ks = 0; ks < 4; ++ks) {
            const bf16x8 k0 = *(const LAS bf16x8*)(Kl + r * KP + (16 * ks + 8 * h) * 2), k1 = *(const LAS bf16x8*)(Kl + (32 + r) * KP + (16 * ks + 8 * h) * 2);
            a0 = mfma32(k0, qf[ks], a0); a1 = mfma32(k1, qf[ks], a1);
        }
        s[0] = a0; s[1] = a1;
    }
    float mx = -INFINITY;
    if (near) {
#pragma unroll
        for (int kh = 0; kh < 2; ++kh)
#pragma unroll
            for (int i = 0; i < 16; ++i) {
                const float v = s[kh][i] * SC2 + tbp[59 - (32 * kh + (i & 3) + 8 * (i >> 2))];
                s[kh][i] = v; mx = fmaxf(mx, v);
                if ((i & 7) == 7) __builtin_amdgcn_sched_barrier(0);
            }
    } else {
#pragma unroll
        for (int kh = 0; kh < 2; ++kh)
#pragma unroll
            for (int i = 0; i < 16; ++i) mx = fmaxf(mx, s[kh][i]);
        mx = mx * SC2 + cadd;
    }
    mx = fmaxf(mx, __shfl_xor(mx, 32));
    const float mn = fmaxf(m, mx);
    const float mu = (mn == -INFINITY) ? 0.f : mn;
    if (__ballot(mn > m) != 0ull) {
        const float alpha = fexp2(m - mu);
        l *= alpha;
#pragma unroll
        for (int d = 0; d < DV / 32; ++d) o[d] *= alpha;
    }
    m = mn;
    float ps = 0.f;
    if (near) {
#pragma unroll
        for (int kh = 0; kh < 2; ++kh)
#pragma unroll
            for (int i = 0; i < 16; ++i) { const float p = fexp2(s[kh][i] - mu); s[kh][i] = p; ps += p; }
    } else {
        const float c2 = cadd - mu, sc2v = SC2;
#pragma unroll
        for (int kh = 0; kh < 2; ++kh)
#pragma unroll
            for (int i = 0; i < 16; ++i) { float a_; asm("v_fma_f32 %0, %1, %2, %3" : "=v"(a_) : "v"(s[kh][i]), "v"(sc2v), "v"(c2)); const float p = fexp2(a_); s[kh][i] = p; ps += p; }
    }
    l += ps;
#pragma unroll
    for (int kh = 0; kh < 2; ++kh)
#pragma unroll
        for (int st = 0; st < 2; ++st) {
            u32x4 pw; pw.x = pk2(s[kh][8 * st + 0], s[kh][8 * st + 1]); pw.y = pk2(s[kh][8 * st + 2], s[kh][8 * st + 3]);
            pw.z = pk2(s[kh][8 * st + 4], s[kh][8 * st + 5]); pw.w = pk2(s[kh][8 * st + 6], s[kh][8 * st + 7]);
            const bf16x8 pf = __builtin_bit_cast(bf16x8, pw);
#pragma unroll
            for (int d = 0; d < DV / 32; ++d) {
                const LAS unsigned char* vp = Vl + (32 * d + r) * VP + (32 * kh + 16 * st + 4 * h) * 2;
                const s16x4 lo = *(const LAS s16x4*)vp, hi4 = *(const LAS s16x4*)(vp + 16);
                const bf16x8 vf = __builtin_shufflevector(lo, hi4, 0, 1, 2, 3, 4, 5, 6, 7);
                o[d] = mfma32(vf, pf, o[d]);
            }
            __builtin_amdgcn_sched_barrier(0);
        }
}

struct AttnCtx {
    const bf16_t* Pp; bf16_t* Yp; const float* tabp;
    const float *lq1, *lk1, *lq2, *lk2, *subg, *sinks;
    float lam_init;
};

template <int KIND>
ATTN_INL void attn_unit(int tid, LAS unsigned char* lds, const AttnCtx& C, int b, int hd, int blk) {
    constexpr int DV = KIND == 0 ? 128 : 64, NKB = KIND == 0 ? 2 : 1, NV = DV / 64;
    constexpr int KBB = 64 * KP, STG = NKB * KBB + DV * VP;
    const int lane = tid & 63, r = lane & 31, h = lane >> 5, w = __builtin_amdgcn_readfirstlane(tid >> 6);
    const size_t tokb = (size_t)b * SEQ;
    const bf16_t* Pb = C.Pp + tokb * INW;
    LAS float* ext = (LAS float*)(lds + AT_EXT);
    int qcol, kcol, vcol, ycol, bh, q0, qw0, t0, t1, kbsel = 0;
    if (KIND == 0) { const int mp = w >> 2; qcol = C_QA + hd * 128 + mp * 64; kcol = C_KA + hd * 128; vcol = C_VA + hd * 128; ycol = hd * 128; bh = hd; q0 = blk * 128; qw0 = q0 + 32 * (w & 3); t0 = 0; t1 = 2 * (blk + 1); kbsel = mp; }
    else if (KIND == 1) { qcol = C_QB + hd * 64; kcol = C_KB + (hd >> 2) * 64; vcol = C_VB + (hd >> 2) * 64; ycol = 512 + hd * 64; bh = 4 + hd; q0 = blk * 256; qw0 = q0 + 32 * w; t0 = (q0 >= 128 ? q0 - 128 : 0) / 64; t1 = (q0 + 256) / 64; }
    else { qcol = C_QC + hd * 64; kcol = C_KC + hd * 64; vcol = C_VC + hd * 64; ycol = 1024 + hd * 64; bh = 12 + hd; q0 = blk * 256; qw0 = q0 + 32 * w; t0 = 0; t1 = 4 * (blk + 1); }

    bf16x8 qf[4];
    { const bf16_t* qp = Pb + (size_t)(qw0 + r) * INW + qcol + 8 * h;
#pragma unroll
      for (int ks = 0; ks < 4; ++ks) qf[ks] = *(const bf16x8*)(qp + 16 * ks); }
    __syncthreads();
    if (tid < 320) { const int dist = tid - 96; const int di = dist < 0 ? 0 : (dist > 128 ? 128 : dist);
        const float tv = C.tabp[bh * TABN + di];
        ext[tid] = (dist < 0 || (KIND == 1 && dist >= 128)) ? -INFINITY : tv; ext[320 + tid] = -INFINITY; }
    unsigned selmask = 0xffu;
    if (KIND == 2) {
        const int ob = blk;
        LAS float* parts = (LAS float*)(lds + AT_PARTS);
        LAS float* km = (LAS float*)(lds + AT_KM);
        LAS unsigned char* sel = lds + AT_SEL;
        {
            const int d2 = tid & 31, kp = tid >> 5;
            for (int j = 0; j < ob; j += 2) {
                const bf16_t* kb = Pb + (size_t)(j * 256 + kp * 16) * INW + kcol + 2 * d2;
                const bool two = j + 1 < ob;
                unsigned wa[16], wb[16];
#pragma unroll
                for (int k = 0; k < 16; ++k) { wa[k] = *(const unsigned*)(kb + (size_t)k * INW); wb[k] = two ? *(const unsigned*)(kb + (size_t)(256 + k) * INW) : 0u; }
                float s0 = 0.f, s1 = 0.f, t0 = 0.f, t1 = 0.f;
#pragma unroll
                for (int k = 0; k < 16; ++k) { s0 += bflo(wa[k]); s1 += bfhi(wa[k]); t0 += bflo(wb[k]); t1 += bfhi(wb[k]); }
                parts[(j * 16 + kp) * 64 + 2 * d2] = s0; parts[(j * 16 + kp) * 64 + 2 * d2 + 1] = s1;
                if (two) { parts[((j + 1) * 16 + kp) * 64 + 2 * d2] = t0; parts[((j + 1) * 16 + kp) * 64 + 2 * d2 + 1] = t1; }
            }
        }
        __syncthreads();
        if (tid < ob * 64) { const int j = tid >> 6, d = tid & 63; float s = 0.f;
#pragma unroll
            for (int k = 0; k < 16; ++k) s += parts[(j * 16 + k) * 64 + d];
            km[j * 64 + d] = s * (1.f / 256.f); }
        __syncthreads();
        {
            const int qi = tid >> 1, hf = tid & 1;
            const bf16_t* qp = Pb + (size_t)(q0 + qi) * INW + qcol + 32 * hf;
            float qv[32];
#pragma unroll
            for (int c = 0; c < 4; ++c) { const u32x4 wv = *(const u32x4*)(qp + 8 * c);
                qv[8 * c + 0] = bflo(wv.x); qv[8 * c + 1] = bfhi(wv.x); qv[8 * c + 2] = bflo(wv.y); qv[8 * c + 3] = bfhi(wv.y);
                qv[8 * c + 4] = bflo(wv.z); qv[8 * c + 5] = bfhi(wv.z); qv[8 * c + 6] = bflo(wv.w); qv[8 * c + 7] = bfhi(wv.w); }
            float gt[7];
#pragma unroll
            for (int j = 0; j < 7; ++j) { float s = 0.f;
                if (j < ob) {
#pragma unroll
                    for (int d = 0; d < 32; ++d) s += qv[d] * km[j * 64 + 32 * hf + d]; }
                s += __shfl_xor(s, 1); gt[j] = s; }
            unsigned msk = 0;
#pragma unroll
            for (int j = 0; j < 7; ++j) { int rank = 0;
#pragma unroll
                for (int i = 0; i < 7; ++i) if (i != j && i < ob) rank += (gt[i] > gt[j] || (gt[i] == gt[j] && i < j)) ? 1 : 0;
                if (j < ob && rank < 3) msk |= 1u << j; }
            if (hf == 0) sel[qi] = (unsigned char)msk;
        }
        __syncthreads();
        selmask = sel[32 * w + r];
    }
    asm volatile("" : "+v"(qf[0]), "+v"(qf[1]), "+v"(qf[2]), "+v"(qf[3]));
    f32x16 o[DV / 32];
#pragma unroll
    for (int d = 0; d < DV / 32; ++d)
#pragma unroll
        for (int i = 0; i < 16; ++i) o[d][i] = 0.f;
    float mrun = -INFINITY, lrun = 0.f;
    const int skey = tid >> 3, sc = tid & 7;
    const int vkey = tid & 63, vc0 = tid >> 6;
    u32x4 kreg[NKB], vreg[NV];
#define AT_LOAD(t) do { const bf16_t* kb_ = Pb + (size_t)((t) * 64 + skey) * INW + kcol + 8 * sc; \
        _Pragma("unroll") for (int nb = 0; nb < NKB; ++nb) kreg[nb] = *(const u32x4*)(kb_ + 64 * nb); \
        const bf16_t* vb_ = Pb + (size_t)((t) * 64 + vkey) * INW + vcol + 8 * vc0; \
        _Pragma("unroll") for (int i = 0; i < NV; ++i) vreg[i] = *(const u32x4*)(vb_ + 64 * i); } while (0)
#define AT_STORE(stg) do { LAS unsigned char* sb_ = lds + (stg) * STG; \
        _Pragma("unroll") for (int nb = 0; nb < NKB; ++nb) *(LAS u32x4*)(sb_ + nb * KBB + skey * KP + 16 * sc) = kreg[nb]; \
        _Pragma("unroll") for (int i = 0; i < NV; ++i) { LAS unsigned char* vt_ = sb_ + NKB * KBB + (8 * (vc0 + 8 * i)) * VP + 2 * vkey; \
            *(LAS unsigned short*)(vt_ + 0 * VP) = (unsigned short)(vreg[i].x & 0xffffu); *(LAS unsigned short*)(vt_ + 1 * VP) = (unsigned short)(vreg[i].x >> 16); \
            *(LAS unsigned short*)(vt_ + 2 * VP) = (unsigned short)(vreg[i].y & 0xffffu); *(LAS unsigned short*)(vt_ + 3 * VP) = (unsigned short)(vreg[i].y >> 16); \
            *(LAS unsigned short*)(vt_ + 4 * VP) = (unsigned short)(vreg[i].z & 0xffffu); *(LAS unsigned short*)(vt_ + 5 * VP) = (unsigned short)(vreg[i].z >> 16); \
            *(LAS unsigned short*)(vt_ + 6 * VP) = (unsigned short)(vreg[i].w & 0xffffu); *(LAS unsigned short*)(vt_ + 7 * VP) = (unsigned short)(vreg[i].w >> 16); } } while (0)
    AT_LOAD(t0); AT_STORE(0);
    __syncthreads();
    const float cfar = ext[96 + 128];
    for (int t = t0; t < t1; ++t) {
        const int stg = (t - t0) & 1;
        if (t + 1 < t1) AT_LOAD(t + 1);
        {
            const int key0 = t * 64;
            bool skip, near, lv = true;
            if (KIND == 0) { skip = key0 > qw0 + 31; near = key0 > qw0 - 191; }
            else if (KIND == 1) { skip = (key0 > qw0 + 31) || (key0 + 63 < qw0 - 127); near = true; }
            else { if (t < 4 * blk) { lv = (selmask >> (t >> 2)) & 1u; skip = __ballot(lv) == 0ull; near = key0 > qw0 - 191; } else { skip = key0 > qw0 + 31; near = key0 > qw0 - 191; } }
            if (!skip) {
                const LAS unsigned char* sb = lds + stg * STG;
                const LAS float* tbp = ext + (lv ? 0 : 320) + (qw0 + r - key0 - 4 * h + 96 - 59);
                wave_tile<DV>(sb + kbsel * KBB, sb + NKB * KBB, tbp, qf, o, mrun, lrun, r, h, near, lv ? cfar : -INFINITY);
            }
        }
        if (t + 1 < t1) AT_STORE(stg ^ 1);
        __syncthreads();
    }
#undef AT_LOAD
#undef AT_STORE
    float ltot = lrun + __shfl_xor(lrun, 32);
    if (KIND == 1) ltot += fexp2(C.sinks[hd] * LOG2E - mrun);
    const float inv = 1.f / ltot;
    bf16_t* yrow = C.Yp + (tokb + qw0 + r) * YW + ycol;
    if (KIND != 0) {
#pragma unroll
        for (int d = 0; d < 2; ++d)
#pragma unroll
            for (int g = 0; g < 4; ++g) { u32x2 wv; wv.x = pk2(o[d][4 * g] * inv, o[d][4 * g + 1] * inv); wv.y = pk2(o[d][4 * g + 2] * inv, o[d][4 * g + 3] * inv);
                *(u32x2*)(yrow + 32 * d + 8 * g + 4 * h) = wv; }
    } else {
        const float s1 = wave_sum(C.lq1[lane] * C.lk1[lane]), s2 = wave_sum(C.lq2[lane] * C.lk2[lane]);
        const float lam = __expf(s1) - __expf(s2) + C.lam_init;
        LAS float* X = (LAS float*)lds;
        const int qi = 32 * (w & 3) + r;
        if (w >= 4) {
#pragma unroll
            for (int d = 0; d < 4; ++d)
#pragma unroll
                for (int g = 0; g < 4; ++g) *(LAS f32x4*)(X + qi * 132 + 32 * d + 8 * g + 4 * h) = (f32x4){o[d][4 * g] * inv, o[d][4 * g + 1] * inv, o[d][4 * g + 2] * inv, o[d][4 * g + 3] * inv};
        }
        __syncthreads();
        if (w < 4) {
            float ss = 0.f;
#pragma unroll
            for (int d = 0; d < 4; ++d)
#pragma unroll
                for (int g = 0; g < 4; ++g) { const f32x4 o2 = *(const LAS f32x4*)(X + qi * 132 + 32 * d + 8 * g + 4 * h);
#pragma unroll
                    for (int e = 0; e < 4; ++e) { const float v = o[d][4 * g + e] * inv - lam * o2[e]; o[d][4 * g + e] = v; ss += v * v; } }
            ss += __shfl_xor(ss, 32);
            const float rs = rsqrtf(ss * (1.f / 128.f) + EPS) * (1.f - C.lam_init);
#pragma unroll
            for (int d = 0; d < 4; ++d)
#pragma unroll
                for (int g = 0; g < 4; ++g) { const int dc = 32 * d + 8 * g + 4 * h; const f32x4 gg = *(const f32x4*)(C.subg + dc);
                    u32x2 wv; wv.x = pk2(o[d][4 * g] * rs * gg[0], o[d][4 * g + 1] * rs * gg[1]); wv.y = pk2(o[d][4 * g + 2] * rs * gg[2], o[d][4 * g + 3] * rs * gg[3]);
                    *(u32x2*)(yrow + dc) = wv; }
        }
    }
}

DI void attn_phase(int tid, LAS unsigned char* lds, const AttnCtx& C, unsigned* ctr, int kindsel) {
    LAS int* nxt = (LAS int*)(lds + AT_MISC);
    for (;;) {
        __syncthreads();
        if (tid == 0) nxt[0] = (int)atomicAdd(ctr, 1u);
        __syncthreads();
        const int i = __builtin_amdgcn_readfirstlane(nxt[0]);
        if (i >= 768) break;
        int tl = tid; asm volatile("" : "+v"(tl));
        if (i < 512) {
            const int g = i >> 6, j = i & 63;
            int bb, hh, kk;
            if (j < 16) { bb = j >> 2; hh = j & 3; kk = 15 - 2 * g; } else if (j >= 48) { bb = (j - 48) >> 2; hh = (j - 48) & 3; kk = 14 - 2 * g; } else { bb = (j - 16) >> 3; hh = (j - 16) & 7; kk = 7 - g; }
            if (j < 16 || j >= 48) { if (kindsel & 1) attn_unit<0>(tl, lds, C, bb, hh, kk); }
            else { if (kindsel & 4) attn_unit<2>(tl, lds, C, bb, hh, kk); }
        } else {
            const int j = i - 512; if (kindsel & 2) attn_unit<1>(tl, lds, C, j >> 6, (j >> 3) & 7, j & 7);
        }
    }
}

DI void row_phase(int gw, int NGW, int lane, const float* xin, const float* y, const float* gpost, const float* gpre, float* xout, bf16_t* xn) {
    for (int m = gw; m < M; m += NGW) {
        const f32x4* xr = (const f32x4*)(xin + (size_t)m * DM) + lane;
        f32x4 v[8];
#pragma unroll
        for (int j = 0; j < 8; ++j) v[j] = xr[64 * j];
        if (y) {
            const f32x4* yr = (const f32x4*)(y + (size_t)m * DM) + lane;
            f32x4 wv[8]; float ss = 0.f;
#pragma unroll
            for (int j = 0; j < 8; ++j) { wv[j] = yr[64 * j]; ss += (wv[j][0] * wv[j][0] + wv[j][1] * wv[j][1]) + (wv[j][2] * wv[j][2] + wv[j][3] * wv[j][3]); }
            const float rs = rsqrtf(wave_sum(ss) * (1.f / DM) + EPS);
            f32x4* xo = (f32x4*)(xout + (size_t)m * DM) + lane;
#pragma unroll
            for (int j = 0; j < 8; ++j) { const f32x4 gp = ((const f32x4*)gpost)[lane + 64 * j]; v[j] += wv[j] * rs * gp; xo[64 * j] = v[j]; }
        }
        if (xn) {
            float ss = 0.f;
#pragma unroll
            for (int j = 0; j < 8; ++j) ss += (v[j][0] * v[j][0] + v[j][1] * v[j][1]) + (v[j][2] * v[j][2] + v[j][3] * v[j][3]);
            const float rs = rsqrtf(wave_sum(ss) * (1.f / DM) + EPS);
            u32x2* xo = (u32x2*)(xn + (size_t)m * DM) + lane;
#pragma unroll
            for (int j = 0; j < 8; ++j) { const f32x4 gp = ((const f32x4*)gpre)[lane + 64 * j]; const f32x4 t = v[j] * rs * gp;
                u32x2 wv; wv.x = pk2(t[0], t[1]); wv.y = pk2(t[2], t[3]); xo[64 * j] = wv; }
        }
    }
}
DI float gelu_tanh(float x) {
    const float z = 1.5957691216057308f * (x + 0.044715f * x * x * x);
    return x * frcp(1.f + fexp2(-z * LOG2E));
}
DI void conv_phase(int gt, int NGT, const bf16_t* U, const float* cw, const float* cb, bf16_t* ACT) {
    constexpr int NCG = DFF / 8, NRC = M / 16;
    for (int it = gt; it < NRC * NCG; it += NGT) {
        const int cgp = it % NCG, rc = it / NCG, tt0 = rc * 16, j0 = cgp * 8;
        float wg[3][8], wv[3][8], bg[8], bvl[8];
#pragma unroll
        for (int k = 0; k < 3; ++k)
#pragma unroll
            for (int e = 0; e < 8; e += 4) { const f32x4 a = *(const f32x4*)(cw + k * UPW + j0 + e), c = *(const f32x4*)(cw + k * UPW + DFF + j0 + e);
#pragma unroll
                for (int q = 0; q < 4; ++q) { wg[k][e + q] = a[q]; wv[k][e + q] = c[q]; } }
#pragma unroll
        for (int e = 0; e < 8; e += 4) { const f32x4 a = *(const f32x4*)(cb + j0 + e), c = *(const f32x4*)(cb + DFF + j0 + e);
#pragma unroll
            for (int q = 0; q < 4; ++q) { bg[e + q] = a[q]; bvl[e + q] = c[q]; } }
        const bf16_t* ug = U + (size_t)tt0 * UPW + j0;
        u32x4 g2 = {0, 0, 0, 0}, g1 = g2, v2 = g2, v1 = g2;
        if ((tt0 & (SEQ - 1)) != 0) { g2 = *(const u32x4*)(ug - 2 * (size_t)UPW); g1 = *(const u32x4*)(ug - (size_t)UPW); v2 = *(const u32x4*)(ug - 2 * (size_t)UPW + DFF); v1 = *(const u32x4*)(ug - (size_t)UPW + DFF); }
#pragma unroll 4
        for (int rr = 0; rr < 16; ++rr) {
            const u32x4 g0 = *(const u32x4*)(ug + (size_t)rr * UPW), v0 = *(const u32x4*)(ug + (size_t)rr * UPW + DFF);
            float res[8];
#pragma unroll
            for (int e = 0; e < 4; ++e) {
                const float a0 = bg[2 * e] + wg[0][2 * e] * bflo(g2[e]) + wg[1][2 * e] * bflo(g1[e]) + wg[2][2 * e] * bflo(g0[e]);
                const float a1 = bg[2 * e + 1] + wg[0][2 * e + 1] * bfhi(g2[e]) + wg[1][2 * e + 1] * bfhi(g1[e]) + wg[2][2 * e + 1] * bfhi(g0[e]);
                const float c0 = bvl[2 * e] + wv[0][2 * e] * bflo(v2[e]) + wv[1][2 * e] * bflo(v1[e]) + wv[2][2 * e] * bflo(v0[e]);
                const float c1 = bvl[2 * e + 1] + wv[0][2 * e + 1] * bfhi(v2[e]) + wv[1][2 * e + 1] * bfhi(v1[e]) + wv[2][2 * e + 1] * bfhi(v0[e]);
                res[2 * e] = gelu_tanh(a0) * c0; res[2 * e + 1] = gelu_tanh(a1) * c1;
            }
            u32x4 ow; ow.x = pk2(res[0], res[1]); ow.y = pk2(res[2], res[3]); ow.z = pk2(res[4], res[5]); ow.w = pk2(res[6], res[7]);
            *(u32x4*)(ACT + (size_t)(tt0 + rr) * DFF + j0) = ow;
            g2 = g1; g1 = g0; v2 = v1; v1 = v0;
        }
    }
}

DI void conv_fix_phase(int gt, int NGT, const float* RAW, const float* cw, const float* cb, bf16_t* ACT) {
    constexpr int NC4 = DFF / 4;
    for (int it = gt; it < (M / 64) * 2 * NC4; it += NGT) {
        const int c4 = it % NC4, rr = (it / NC4) & 1, gidx = it / (2 * NC4), j0 = 4 * c4, ic = 256 * (j0 >> 7) + (j0 & 127);
        const bool hasprev = (gidx & 31) != 0;
        const float* own = RAW + (size_t)gidx * 4 * UPW + ic; const float* prv = own - (size_t)4 * UPW;
        const f32x4 z4 = {0.f, 0.f, 0.f, 0.f};
        f32x4 x0g, x1g, x2g, x0v, x1v, x2v;
        x0g = *(const f32x4*)(own + (size_t)rr * UPW); x0v = *(const f32x4*)(own + (size_t)rr * UPW + 128);
        if (rr) { x1g = *(const f32x4*)(own); x1v = *(const f32x4*)(own + 128); x2g = hasprev ? *(const f32x4*)(prv + (size_t)3 * UPW) : z4; x2v = hasprev ? *(const f32x4*)(prv + (size_t)3 * UPW + 128) : z4; }
        else { x1g = hasprev ? *(const f32x4*)(prv + (size_t)3 * UPW) : z4; x1v = hasprev ? *(const f32x4*)(prv + (size_t)3 * UPW + 128) : z4;
               x2g = hasprev ? *(const f32x4*)(prv + (size_t)2 * UPW) : z4; x2v = hasprev ? *(const f32x4*)(prv + (size_t)2 * UPW + 128) : z4; }
        float res[4];
        const f32x4 bg = *(const f32x4*)(cb + j0), bv = *(const f32x4*)(cb + DFF + j0);
        const f32x4 w0g = *(const f32x4*)(cw + j0), w1g = *(const f32x4*)(cw + UPW + j0), w2g = *(const f32x4*)(cw + 2 * UPW + j0);
        const f32x4 w0v = *(const f32x4*)(cw + DFF + j0), w1v = *(const f32x4*)(cw + UPW + DFF + j0), w2v = *(const f32x4*)(cw + 2 * UPW + DFF + j0);
#pragma unroll
        for (int e = 0; e < 4; ++e) { const float cgv = bg[e] + w0g[e] * x2g[e] + w1g[e] * x1g[e] + w2g[e] * x0g[e], cvv = bv[e] + w0v[e] * x2v[e] + w1v[e] * x1v[e] + w2v[e] * x0v[e];
            res[e] = pg8::gelu_t(cgv) * cvv; }
        u32x2 w; w.x = pk2(res[0], res[1]); w.y = pk2(res[2], res[3]);
        *(u32x2*)(ACT + (size_t)(gidx * 64 + rr) * DFF + j0) = w;
    }
}

template <bool UPMAP = false>
DI void transpose_item(const float* W, int K, int N, bf16_t* WT, LAS float* scr, int item, int lane) {
    const int nblk = N / 32, kb = item / nblk, nb = item % nblk, k0 = 64 * kb, n0 = 32 * nb;
    int r0 = n0;
    if (UPMAP) { const int j = n0 >= DFF ? n0 - DFF : n0; r0 = 256 * (j >> 7) + (j & 127) + (n0 >= DFF ? 128 : 0); }
    float v[32];
    const float* src = W + (size_t)(k0 + (lane >> 5)) * N + n0 + (lane & 31);
#pragma unroll
    for (int i = 0; i < 32; ++i) v[i] = src[(size_t)(2 * i) * N];
#pragma unroll
    for (int i = 0; i < 32; ++i) scr[(2 * i + (lane >> 5)) * 33 + (lane & 31)] = v[i];
    asm volatile("s_waitcnt lgkmcnt(0)" ::: "memory");
    const int c = lane & 7;
#pragma unroll
    for (int j = 0; j < 4; ++j) { const int n = (lane >> 3) + 8 * j; const LAS float* s = scr + (8 * c) * 33 + n;
        u32x4 o; o.x = pk2(s[0 * 33], s[1 * 33]); o.y = pk2(s[2 * 33], s[3 * 33]); o.z = pk2(s[4 * 33], s[5 * 33]); o.w = pk2(s[6 * 33], s[7 * 33]);
        *(u32x4*)(WT + (size_t)(r0 + n) * K + k0 + 8 * c) = o; }
    asm volatile("s_waitcnt lgkmcnt(0)" ::: "memory");
}

#define XB_TMO      128
#define XB_XCNT(j)  (256  + 64 * (j))
#define XB_XSUB(j)  (1280 + 64 * (j))
#define XB_XGEN(j)  (2304 + 64 * (j))
#define XB_TOP      3328
#define XB_TOPGEN   3392
#define XCD_BAR_WORDS 3456
#define XB_SPIN_CAP (1u << 22)
constexpr int CW_BAR = 4096;
DI unsigned xb_ld(unsigned* p)              { return __hip_atomic_load(p, __ATOMIC_RELAXED, __HIP_MEMORY_SCOPE_AGENT); }
DI unsigned xb_add(unsigned* p, unsigned v) { return __hip_atomic_fetch_add(p, v, __ATOMIC_RELAXED, __HIP_MEMORY_SCOPE_AGENT); }
DI unsigned xb_xcc_id() { return (unsigned)__builtin_amdgcn_s_getreg((3 << 11) | 20) & 0xFu; }
#define XB_SPIN(cond, bar) do { unsigned _sp = 0; while (cond) { __builtin_amdgcn_s_sleep(1); \
    if ((++_sp & 255u) == 0u) { if (xb_ld(&(bar)[XB_TMO])) break; if (_sp > XB_SPIN_CAP) { atomicAdd(&(bar)[XB_TMO], 1u); break; } } } } while (0)
struct XcdBarrier { unsigned* bar; unsigned x; volatile LAS unsigned* st; };
DI XcdBarrier xcd_barrier_post(unsigned* bar, volatile LAS unsigned* st) {
    XcdBarrier b; b.bar = bar; b.x = xb_xcc_id(); b.st = st;
    if (threadIdx.x == 0) (void)xb_add(&bar[XB_XCNT(b.x)], 1u);
    return b;
}
DI void xcd_barrier_complete(unsigned* bar, unsigned x, unsigned& nloc, unsigned& nx) {
    const unsigned G = gridDim.x * gridDim.y * gridDim.z;
    unsigned sum, cnt, mine, sp = 0u;
    for (;;) {
        sum = 0u; cnt = 0u; mine = 0u;
#pragma unroll
        for (unsigned j = 0; j < 16; ++j) { const unsigned c = xb_ld(&bar[XB_XCNT(j)]); sum += c; cnt += (c > 0u) ? 1u : 0u; mine = (j == x) ? c : mine; }
        if (sum == G) break;
        __builtin_amdgcn_s_sleep(1);
        if ((++sp & 255u) == 0u) { if (xb_ld(&bar[XB_TMO])) break; if (sp > XB_SPIN_CAP) { atomicAdd(&bar[XB_TMO], 1u); break; } }
    }
    nloc = mine > 0u ? mine : 1u; nx = cnt > 0u ? cnt : 1u;
}
DI void xcd_barrier(const XcdBarrier& b) {
    asm volatile("s_waitcnt vmcnt(0)" ::: "memory");
    __syncthreads();
    if (threadIdx.x == 0) {
        unsigned* bar = b.bar;
        __builtin_amdgcn_s_waitcnt(0);
        unsigned nloc = b.st[0], nx = b.st[1];
        if (nloc == 0u) { xcd_barrier_complete(bar, b.x, nloc, nx); b.st[0] = nloc; b.st[1] = nx; }
        const unsigned old = xb_add(&bar[XB_XSUB(b.x)], 1u);
        const unsigned gen = old / nloc;
        if (old + 1u == (gen + 1u) * nloc) {
            __builtin_amdgcn_fence(__ATOMIC_RELEASE, "agent");
            asm volatile("s_waitcnt vmcnt(0)" ::: "memory");
            const unsigned og = xb_add(&bar[XB_TOP], 1u);
            const unsigned tg = og / nx;
            if (og + 1u == (tg + 1u) * nx) xb_add(&bar[XB_TOPGEN], 1u);
            else XB_SPIN(xb_ld(&bar[XB_TOPGEN]) == tg, bar);
            __builtin_amdgcn_fence(__ATOMIC_ACQUIRE, "agent");
            xb_add(&bar[XB_XGEN(b.x)], 1u);
            asm volatile("s_waitcnt vmcnt(0)" ::: "memory");
        } else {
            XB_SPIN(xb_ld(&bar[XB_XGEN(b.x)]) == gen, bar);
            __builtin_amdgcn_fence(__ATOMIC_ACQUIRE, "agent");
            asm volatile("s_waitcnt vmcnt(0)" ::: "memory");
        }
    }
    __syncthreads();
}

struct Args { const float* in[22]; float* out; unsigned char* ws; int ph_lo, ph_hi; };
#ifndef PROBE_SP
#define PROBE_SP (-1)
#endif
constexpr int SLOTS = 9 + (PROBE_SP >= 0 ? 1 : 0), N_PHASES = 1 + SLOTS * DEPTH;

__global__ void __launch_bounds__(512, 2) fwd_kernel(Args args) {
    extern __shared__ __attribute__((aligned(16))) unsigned char lds_raw[];
    LAS unsigned char* lds = (LAS unsigned char*)lds_raw;
    cg::grid_group grid = cg::this_grid();
    const int G = gridDim.x, bx = blockIdx.x, NGW = G * 8;
    unsigned char* ws = args.ws;
    unsigned* ctl = (unsigned*)(ws + WS_CTL);
#define tabg   ((float*)(ws + WS_TAB))
#define Win_t  ((bf16_t*)(ws + WS_WIN))
#define Wo3_t  ((bf16_t*)(ws + WS_WO3))
#define Wout_t ((bf16_t*)(ws + WS_WOUT))
#define Wup_t  ((bf16_t*)(ws + WS_WUP))
#define Wdn_t  ((bf16_t*)(ws + WS_WDN))
#define XN     ((bf16_t*)(ws + WS_XN))
#define P      ((bf16_t*)(ws + WS_P))
#define Y      ((bf16_t*)(ws + WS_Y))
#define TMP    ((float*)(ws + WS_TMP))
#define MIX    ((bf16_t*)(ws + WS_MIX))
#define U      ((bf16_t*)(ws + WS_U))
#define ACT    ((bf16_t*)(ws + WS_ACT))
    const float* x_in = args.in[0];
    float* xres = args.out;
    constexpr int I_IN = 32 * (INW / 32), I_O = 8 * 64, I_OUT = 32 * 64, I_UP = 32 * (UPW / 32), I_DN = 88 * 64, I_L = I_IN + 3 * I_O + I_OUT + I_UP + I_DN, I_DEFA = 0;
    const bool defer = (G == 256);
#define CONVERT_ITEM(l_, rI_) do { const int l__ = (l_); int r__ = (rI_); LAS float* scr__ = (LAS float*)(lds + wave * 16384); \
        if (r__ < I_IN) { transpose_item(args.in[2] + (size_t)l__ * DM * INW, DM, INW, Win_t + (size_t)l__ * INW * DM, scr__, r__, lane); break; } r__ -= I_IN; \
        if (r__ < 3 * I_O) { const int br__ = r__ / I_O; transpose_item(args.in[10 + br__] + (size_t)l__ * 512 * DM, 512, DM, Wo3_t + (size_t)(l__ * 3 + br__) * DM * 512, scr__, r__ % I_O, lane); break; } r__ -= 3 * I_O; \
        if (r__ < I_OUT) { transpose_item(args.in[13] + (size_t)l__ * DM * DM, DM, DM, Wout_t + (size_t)l__ * DM * DM, scr__, r__, lane); break; } r__ -= I_OUT; \
        if (r__ < I_UP) { transpose_item<true>(args.in[18] + (size_t)l__ * DM * UPW, DM, UPW, Wup_t + (size_t)l__ * UPW * DM, scr__, r__, lane); break; } r__ -= I_UP; \
        transpose_item(args.in[21] + (size_t)l__ * DFF * DM, DFF, DM, Wdn_t + (size_t)l__ * DM * DFF, scr__, r__, lane); } while (0)
    const bool fusedln = (G == 256);
    for (int u = threadIdx.x; u < (LDS_BYTES - 131072) / 4; u += 512) ((LAS unsigned*)(lds + 131072))[u] = 0u;
    __syncthreads();
    XcdBarrier xbar; xbar.bar = ctl + CW_BAR; xbar.x = 0; xbar.st = nullptr;
    if (args.ph_hi - args.ph_lo > 1) xbar = xcd_barrier_post(ctl + CW_BAR, (volatile LAS unsigned*)(lds + 131072 + 320) + 8);
    int nsync = 0;

    for (int ph = args.ph_lo; ph < args.ph_hi; ++ph) {
      const int q_ = ph > 0 ? (ph - 1) % SLOTS : 0;
      const int l = ph > 0 ? (ph - 1) / SLOTS : 0, sp = (PROBE_SP >= 0 && q_ > PROBE_SP) ? q_ - 1 : q_;
      const int rep = (PROBE_SP >= 0 && q_ == PROBE_SP + 1) ? 1 : 0;
      if (ph > 0 && fusedln && (sp == 4 || sp == 8)) continue;
      {
        if (ph > args.ph_lo) { if (nsync == 0 || !USE_XCD_BAR) grid.sync(); else xcd_barrier(xbar); ++nsync; }
        int tid = threadIdx.x; asm volatile("" : "+v"(tid));
        const int lane = tid & 63, wave = __builtin_amdgcn_readfirstlane(tid >> 6), gw = bx * 8 + wave;
        if (ph == 0) {
#if PH_MASK & 1
            if (bx == 0) {
                for (int idx = tid; idx < 20 * 129; idx += 512) { const int hh = idx / 129, d = idx % 129; int bkt;
                    if (d < 16) bkt = d; else { bkt = 16 + (int)(logf((float)d / 16.f) / 2.0794415416798357f * 16.f); bkt = bkt > 31 ? 31 : bkt; }
                    tabg[hh * TABN + d] = args.in[1][bkt * 20 + hh] * LOG2E; }
            }
            for (int it = gw; it < DEPTH * I_L; it += NGW) {
                const int l = it / I_L, rI = it % I_L;
                if (defer && l > 0 && ((rI >= I_IN && rI < I_IN + I_DEFA) || rI >= I_L - I_DN)) continue;
                CONVERT_ITEM(l, rI);
            }
            row_phase(gw, NGW, lane, x_in, nullptr, nullptr, args.in[14], nullptr, XN);
#endif
            continue;
        }
        if (0) {}
#if PH_MASK & 2
        else if (sp == 0) {
            pg8::Gemm g{XN, Win_t + (size_t)l * INW * DM, DM, DM, DM, 0, 0}; pg8::StaticOrder S; S.init(M, INW, G, bx);
            pg8::EpiProj E{P, args.in[3] + (size_t)l * 3 * DM};
            pg8::gemm_phase<pg8::EpiProj, pg8::StaticOrder, true>(tid, lds, g, S, E);
        }
#endif
#if PH_MASK & 4
        else if (sp == 1) {
            AttnCtx C; C.Pp = P; C.Yp = Y; C.tabp = tabg; C.lq1 = args.in[4] + l * 64; C.lk1 = args.in[5] + l * 64; C.lq2 = args.in[6] + l * 64; C.lk2 = args.in[7] + l * 64;
            C.subg = args.in[8] + l * 128; C.sinks = args.in[9] + l * 8; C.lam_init = 0.8f - 0.6f * __expf(-0.3f * (float)l);
            attn_phase(tid, lds, C, ctl + 64 * (1 + l + 8 * rep), rep ? DUP_KIND : 7);
        }
#endif
#if PH_MASK & 8
        else if (sp == 2) {
            pg8::Gemm g{Y, Wo3_t + (size_t)l * 3 * DM * 512, YW, 512, 512, 512, (long)DM * 512}; pg8::BranchOrder S; S.init(M, DM, G, bx);
            pg8::EpiBranch E{P, MIX};
            pg8::gemm_phase<pg8::EpiBranch, pg8::BranchOrder, true>(tid, lds, g, S, E);
        }
#endif
#if PH_MASK & 16
        else if (sp == 3 || sp == 7) {
            pg8::Gemm g = (sp == 3) ? pg8::Gemm{MIX, Wout_t + (size_t)l * DM * DM, DM, DM, DM, 0, 0} : pg8::Gemm{ACT, Wdn_t + (size_t)l * DM * DFF, DFF, DFF, DFF, 0, 0};
            pg8::StaticOrder S; S.init(M, DM, G, bx);
            if (fusedln) {
                const int k = l * 4 + (sp == 3 ? 0 : 2); float* xb = (float*)(ws + WS_XB);
                const pg8::RowStats s1{xb + (size_t)k * M * 8, ctl + CW_SEAM + k * 2048}, s2{xb + (size_t)(k + 1) * M * 8, ctl + CW_SEAM + (k + 1) * 2048};
                const bool more = (sp == 3) || (l + 1 < DEPTH);
                pg8::EpiNormRes E{(sp == 3 && l == 0) ? x_in : xres, xres, more ? XN : nullptr, (sp == 3 ? args.in[15] : args.in[17]) + l * DM,
                                  sp == 3 ? args.in[16] + l * DM : args.in[14] + (l + 1 < DEPTH ? l + 1 : 0) * DM, s1, s2};
                pg8::gemm_phase<pg8::EpiNormRes, pg8::StaticOrder, false>(tid, lds, g, S, E);
            } else {
                pg8::EpiF32 E{TMP};
                pg8::gemm_phase<pg8::EpiF32, pg8::StaticOrder, true>(tid, lds, g, S, E);
            }
        }
#endif
#if PH_MASK & 32
        else if (sp == 4) {
            row_phase(gw, NGW, lane, l == 0 ? x_in : xres, TMP, args.in[15] + l * DM, args.in[16] + l * DM, xres, XN);
        }
#endif
#if PH_MASK & 64
        else if (sp == 5) {
            pg8::Gemm g{XN, Wup_t + (size_t)l * UPW * DM, DM, DM, DM, 0, 0}; pg8::StaticOrder S; S.init(M, UPW, G, bx);
            pg8::EpiUpConv E{ACT, (float*)U, args.in[19] + (size_t)l * 3 * UPW, args.in[20] + (size_t)l * UPW};
            pg8::gemm_phase<pg8::EpiUpConv, pg8::StaticOrder, true>(tid, lds, g, S, E);
            if (defer && l + 1 < DEPTH && bx >= 128) {
                for (int k = (bx - 128) * 8 + wave; k < I_DEFA + I_DN; k += 128 * 8) CONVERT_ITEM(l + 1, k < I_DEFA ? I_IN + k : I_L - I_DN + (k - I_DEFA));
            }
        }
#endif
#if PH_MASK & 128
        else if (sp == 6) {
            conv_fix_phase(bx * 512 + tid, G * 512, (const float*)U, args.in[19] + (size_t)l * 3 * UPW, args.in[20] + (size_t)l * UPW, ACT);
        }
#endif
#if PH_MASK & 256
        else {
            row_phase(gw, NGW, lane, xres, TMP, args.in[17] + l * DM, l + 1 < DEPTH ? args.in[14] + (l + 1) * DM : nullptr, xres, l + 1 < DEPTH ? XN : nullptr);
        }
#endif
      }
    }
}

#undef tabg
#undef Win_t
#undef Wo3_t
#undef Wout_t
#undef Wup_t
#undef Wdn_t
#undef XN
#undef P
#undef Y
#undef TMP
#undef MIX
#undef U
#undef ACT
extern "C" void kernel_launch(void* const* d_in, const int* in_sizes, int n_in, void* d_out, int out_size, void* d_ws, size_t ws_size, hipStream_t stream) {
    static int grid = 0;
    if (grid == 0) {
        if (n_in != 22 || out_size != M * DM || ws_size < WS_END) { fprintf(stderr, "kernel_launch: unexpected problem (n_in %d out %d ws %zu)\n", n_in, out_size, ws_size); grid = -1; return; }
        int dev = 0, cus = 0, per_cu = 0;
        hipGetDevice(&dev); hipDeviceGetAttribute(&cus, hipDeviceAttributeMultiprocessorCount, dev);
        hipFuncSetAttribute((const void*)fwd_kernel, hipFuncAttributeMaxDynamicSharedMemorySize, LDS_BYTES);
        hipOccupancyMaxActiveBlocksPerMultiprocessor(&per_cu, (const void*)fwd_kernel, 512, LDS_BYTES);
        (void)hipGetLastError();
        if (per_cu < 1) { fprintf(stderr, "kernel_launch: occupancy query says %d blocks per CU\n", per_cu); per_cu = 1; }
        grid = cus;
        fprintf(stderr, "kernel_launch: grid %d (per_cu %d)\n", grid, per_cu);
    }
    if (grid < 0) return;
    hipMemsetAsync((char*)d_ws + WS_CTL, 0, CTL_ZERO_BYTES, stream);
    Args a{};
    for (int i = 0; i < 22; ++i) a.in[i] = (const float*)d_in[i];
    a.out = (float*)d_out; a.ws = (unsigned char*)d_ws;
#if N_LAUNCH_MODE == 1
    a.ph_lo = 0; a.ph_hi = N_PHASES;
    void* kargs[] = {&a};
    hipError_t e = hipLaunchCooperativeKernel((const void*)fwd_kernel, dim3(grid), dim3(512), kargs, LDS_BYTES, stream);
    if (e != hipSuccess) fprintf(stderr, "cooperative launch failed: %s (grid %d)\n", hipGetErrorString(e), grid);
#else
    for (int ph = 0; ph < N_PHASES; ++ph) { a.ph_lo = ph; a.ph_hi = ph + 1; hipLaunchKernelGGL(fwd_kernel, dim3(grid), dim3(512), LDS_BYTES, stream, a); }
#endif
}
```

```cpp
#include <hip/hip_runtime.h>
#include <hip/hip_cooperative_groups.h>
#include <cstdio>
#include <cstdint>
namespace cg = cooperative_groups;

#ifndef PH_MASK
#define PH_MASK 511
#endif
#ifndef ATTN_INL
#define ATTN_INL __device__ __forceinline__
#endif
#ifndef KIND_MASK
#define KIND_MASK 7
#endif
#ifndef USE_XCD_BAR
#define USE_XCD_BAR 1
#endif
#ifndef DUP_KIND
#define DUP_KIND 7
#endif
#ifndef N_LAUNCH_MODE
#define N_LAUNCH_MODE 1
#endif

#define DI __device__ __forceinline__
#define LAS __attribute__((address_space(3)))
typedef unsigned short bf16_t;
typedef short bf16x8 __attribute__((ext_vector_type(8)));
typedef short s16x4 __attribute__((ext_vector_type(4)));
typedef float f32x4 __attribute__((ext_vector_type(4)));
typedef float f32x2 __attribute__((ext_vector_type(2)));
typedef float f32x16 __attribute__((ext_vector_type(16)));
typedef unsigned u32x4 __attribute__((ext_vector_type(4)));
typedef unsigned u32x2 __attribute__((ext_vector_type(2)));
typedef __bf16 bf16x2n __attribute__((ext_vector_type(2)));

constexpr int DM = 2048, NB = 4, SEQ = 2048, DEPTH = 4, M = NB * SEQ;
constexpr int INW = 9984, DFF = 5632, UPW = 11264, YW = 1536;
constexpr int C_QA = 0, C_KA = 512, C_VA = 1024, C_QB = 1536, C_KB = 2048, C_VB = 2176, C_QC = 2304, C_KC = 2816, C_VC = 3328, C_G = 3840;
constexpr float EPS = 1e-6f;
constexpr float LOG2E = 1.4426950408889634f;
constexpr float SC2 = 0.125f * LOG2E;
constexpr int TABN = 132;

constexpr size_t MiB = 1u << 20;
constexpr size_t WS_CTL = 0, CTL_ZERO_BYTES = 1 * MiB;
constexpr size_t WS_TAB = 1 * MiB;
constexpr size_t WS_WIN = 2 * MiB, WS_WO3 = 158 * MiB, WS_WOUT = 182 * MiB, WS_WUP = 214 * MiB, WS_WDN = 390 * MiB;
constexpr size_t WS_XN = 478 * MiB, WS_P = 510 * MiB, WS_Y = 666 * MiB, WS_TMP = 690 * MiB, WS_MIX = 754 * MiB, WS_U = 786 * MiB, WS_ACT = 962 * MiB, WS_XB = 1050 * MiB, WS_END = 1054 * MiB;
constexpr int CW_SEAM = 16384;
constexpr int LDS_BYTES = 147456;

DI unsigned pk2(float lo, float hi) { f32x2 v = {lo, hi}; return __builtin_bit_cast(unsigned, __builtin_convertvector(v, bf16x2n)); }
DI float bflo(unsigned w) { return __uint_as_float(w << 16); }
DI float bfhi(unsigned w) { return __uint_as_float(w & 0xffff0000u); }
DI float wave_sum(float v) {
#pragma unroll
    for (int o = 1; o < 64; o <<= 1) v += __shfl_xor(v, o);
    return v;
}
DI float fexp2(float x) { return __builtin_amdgcn_exp2f(x); }
DI float frcp(float x) { return __builtin_amdgcn_rcpf(x); }

namespace pg8 {
constexpr int BM = 256, BK = 64, HALF = 128, HTB = HALF * BK * 2, STAGE_BYTES = 8 * HTB, NXCD = 8, WGM = 8;
DI int lds_byte(int r, int c) { const int st = (r >> 4) * 2 + (c >> 5), rr = r & 15, cc = c & 31, ob = rr * 64 + cc * 2; return st * 1024 + (ob ^ (((ob >> 9) & 1) << 5)); }
DI void stage_rc(int b, int& R, int& C) { const int st = b / 1024, sb = b % 1024, swz = sb ^ (((sb >> 9) & 1) << 5); R = (st >> 1) * 16 + swz / 64; C = (st & 1) * 32 + (swz % 64) / 2; }
DI int perm32(int rho) { const int n = rho >> 4, i = rho & 15; return 8 * (i >> 2) + 4 * n + (i & 3); }

struct Unit { int pm, pn, z; };
struct Gemm { const bf16_t* A; const bf16_t* Bt; int lda, ldb, K; long zA, zB; };

DI void tile_of(int wgid, int nM, int nN, Unit& u) {
    const int nwg = nM * nN;
    { const int q = nwg / NXCD, r = nwg % NXCD, xcd = wgid % NXCD, off = wgid / NXCD; wgid = (xcd < r ? xcd * (q + 1) : r * (q + 1) + (xcd - r) * q) + off; }
    const int nig = WGM * nN, gid = wgid / nig, fm = gid * WGM, gsz = (nM - fm) < WGM ? (nM - fm) : WGM;
    u.pm = fm + ((wgid % nig) % gsz); u.pn = (wgid % nig) / gsz;
}
struct StaticOrder {
    int nM, nN, nwg, G, c;
    DI void init(int M_, int N_, int G_, int c_) { nM = M_ / BM; nN = N_ / BM; nwg = nM * nN; G = G_; c = c_; }
    DI bool next(int i, Unit& u) const {
        const long L = (long)i * G + c; if (L >= nwg) return false;
        tile_of((int)L, nM, nN, u); u.z = 0; return true;
    }
};
struct BranchOrder {
    int nM, nN, nwg, G, c;
    DI void init(int M_, int N_, int G_, int c_) { nM = M_ / BM; nN = N_ / BM; nwg = nM * nN; G = G_; c = c_; }
    DI bool next(int i, Unit& u) const {
        const long L = (long)(i / 3) * G + c; if (L >= nwg) return false;
        tile_of((int)L, nM, nN, u); u.z = i % 3; return true;
    }
};

typedef f32x4 Acc[2][2][4][2];

template <class Epi, class Sched, bool ALIGN_EPI>
DI void gemm_phase(int tid, LAS unsigned char* lds, const Gemm g, const Sched& S, const Epi& E) {
    const int wid = __builtin_amdgcn_readfirstlane(tid >> 6), lane = tid & 63, wr = wid >> 2, wc = wid & 3, fr = lane & 15, fq = lane >> 4;
    const int K = g.K, nt = K / BK;
    unsigned voffA[2], voffB[2];
#pragma unroll
    for (int i = 0; i < 2; ++i) { int R, C; stage_rc(tid * 16 + i * 8192, R, C); const int Rb = Epi::PERM ? ((R & ~31) + perm32(R & 31)) : R;
        voffA[i] = (unsigned)(R * g.lda + C) * 2u; voffB[i] = (unsigned)(Rb * g.ldb + C) * 2u; }
    const size_t kstep = (size_t)(BK * 2);
    const size_t hA = (size_t)HALF * g.lda * 2, hB = (size_t)HALF * g.ldb * 2, tA = 2 * hA, tB = 2 * hB;
    const unsigned ldsw = (unsigned)wid * 1024u;
    const int aoff = lds_byte(wr * 64 + fr, fq * 8), boff = lds_byte(wc * 32 + fr, fq * 8);
#define PG8_SA(b, h) (((b) * 2 + (h)) * HTB)
#define PG8_SB(b, h) ((4 + (b) * 2 + (h)) * HTB)
#define PG8_STAGE(bufoff, gbase, voff) do { _Pragma("unroll") for (int _i = 0; _i < 2; ++_i) \
        __builtin_amdgcn_global_load_lds((const unsigned*)((const char*)(gbase) + (voff)[_i]), (LAS unsigned*)(lds + (bufoff) + ldsw + _i * 8192), 16, 0, 0); } while (0)
#define PG8_LDA(dst, b, h) do { _Pragma("unroll") for (int m = 0; m < 4; ++m) _Pragma("unroll") for (int k = 0; k < 2; ++k) dst[m][k] = *(const LAS bf16x8*)(lds + PG8_SA(b, h) + aoff + m * 2048 + k * 1024); } while (0)
#define PG8_LDB(dst, b, h) do { _Pragma("unroll") for (int n = 0; n < 2; ++n) _Pragma("unroll") for (int k = 0; k < 2; ++k) dst[n][k] = *(const LAS bf16x8*)(lds + PG8_SB(b, h) + boff + n * 2048 + k * 1024); } while (0)
#define PG8_MMA(ai, bj, At, Bt) do { __builtin_amdgcn_s_setprio(1); _Pragma("unroll") for (int m = 0; m < 4; ++m) _Pragma("unroll") for (int n = 0; n < 2; ++n) _Pragma("unroll") for (int k = 0; k < 2; ++k) \
        acc[ai][bj][m][n] = __builtin_amdgcn_mfma_f32_16x16x32_bf16(Bt[n][k], At[m][k], acc[ai][bj][m][n], 0, 0, 0); __builtin_amdgcn_s_setprio(0); } while (0)
#define PG8_WAIT_V(n) asm volatile("s_waitcnt vmcnt(" #n ")" ::: "memory")
#define PG8_WAIT_L(n) asm volatile("s_waitcnt lgkmcnt(" #n ")" ::: "memory")
#define PG8_BAR __builtin_amdgcn_s_barrier()
#define PG8_SCHED __builtin_amdgcn_sched_barrier(0)
    Unit cur, nxt; int ui = 0;
    if (!S.next(0, cur)) return;
    Acc acc;
#pragma unroll
    for (int a = 0; a < 2; ++a)
#pragma unroll
        for (int b = 0; b < 2; ++b)
#pragma unroll
            for (int m = 0; m < 4; ++m)
#pragma unroll
                for (int n = 0; n < 2; ++n) acc[a][b][m][n] = (f32x4){0.f, 0.f, 0.f, 0.f};
    bf16x8 At[4][2], B0[2][2], B1[2][2];
    const char* cA = (const char*)(g.A + (size_t)cur.z * g.zA) + (size_t)cur.pm * tA; const char* cB = (const char*)(g.Bt + (size_t)cur.z * g.zB) + (size_t)cur.pn * tB;
    PG8_STAGE(PG8_SB(0, 0), cB, voffB); PG8_STAGE(PG8_SB(0, 1), cB + hB, voffB); PG8_STAGE(PG8_SA(0, 0), cA, voffA); PG8_STAGE(PG8_SA(0, 1), cA + hA, voffA);
    if (wr == 1) PG8_BAR;
    PG8_WAIT_V(2); PG8_BAR;
    PG8_STAGE(PG8_SB(1, 0), cB + kstep, voffB); PG8_STAGE(PG8_SA(1, 0), cA + kstep, voffA); PG8_STAGE(PG8_SB(1, 1), cB + hB + kstep, voffB);
    PG8_WAIT_V(6); PG8_BAR;
    for (;;) {
        const bool has_next = S.next(ui + 1, nxt);
        const char* nA = has_next ? (const char*)(g.A + (size_t)nxt.z * g.zA) + (size_t)nxt.pm * tA : cA; const char* nB = has_next ? (const char*)(g.Bt + (size_t)nxt.z * g.zB) + (size_t)nxt.pn * tB : cB;
        for (int t = 0; t < nt; t += 2) {
            const bool last = (t == nt - 2);
            const char* a1 = cA + (size_t)(t + 1) * kstep;
            const char* a2 = last ? nA : cA + (size_t)(t + 2) * kstep; const char* b2 = last ? nB : cB + (size_t)(t + 2) * kstep;
            const char* a3 = a2 + kstep; const char* b3 = b2 + kstep;
            PG8_LDB(B0, 0, 0); PG8_LDB(B1, 0, 1); PG8_SCHED; PG8_LDA(At, 0, 0); PG8_STAGE(PG8_SA(1, 1), a1 + hA, voffA);
            PG8_WAIT_V(8); PG8_WAIT_L(0); PG8_BAR; PG8_MMA(0, 0, At, B0); PG8_MMA(0, 1, At, B1); PG8_BAR; PG8_SCHED;
            PG8_LDA(At, 0, 1); PG8_STAGE(PG8_SB(0, 0), b2, voffB); PG8_STAGE(PG8_SB(0, 1), b2 + hB, voffB); PG8_STAGE(PG8_SA(0, 0), a2, voffA);
            PG8_WAIT_V(8); PG8_WAIT_L(0); PG8_BAR; PG8_MMA(1, 0, At, B0); PG8_MMA(1, 1, At, B1); PG8_BAR; PG8_SCHED;
            PG8_LDB(B0, 1, 0); PG8_LDB(B1, 1, 1); PG8_SCHED; PG8_LDA(At, 1, 0); PG8_STAGE(PG8_SA(0, 1), a2 + hA, voffA);
            PG8_WAIT_V(8); PG8_WAIT_L(0); PG8_BAR; PG8_MMA(0, 0, At, B0); PG8_MMA(0, 1, At, B1); PG8_BAR; PG8_SCHED;
            PG8_LDA(At, 1, 1); PG8_STAGE(PG8_SB(1, 0), b3, voffB); PG8_STAGE(PG8_SB(1, 1), b3 + hB, voffB); PG8_STAGE(PG8_SA(1, 0), a3, voffA);
            PG8_WAIT_V(8); PG8_WAIT_L(0); PG8_BAR; PG8_MMA(1, 0, At, B0); PG8_MMA(1, 1, At, B1); PG8_BAR; PG8_SCHED;
        }
        if constexpr (ALIGN_EPI) { if (wr == 0) PG8_BAR; }
        if constexpr (!Epi::AFTER_DRAIN) E(acc, cur, wr, wc, fr, fq);
        if (!has_next) break;
        if (!(Epi::KEEP_ACC && nxt.z != 0))
#pragma unroll
        for (int a = 0; a < 2; ++a)
#pragma unroll
            for (int b = 0; b < 2; ++b)
#pragma unroll
                for (int m = 0; m < 4; ++m)
#pragma unroll
                    for (int n = 0; n < 2; ++n) acc[a][b][m][n] = (f32x4){0.f, 0.f, 0.f, 0.f};
        cur = nxt; cA = nA; cB = nB; ++ui;
        if constexpr (ALIGN_EPI) { if (wr == 1) PG8_BAR; }
    }
    PG8_WAIT_V(0);
    if constexpr (!ALIGN_EPI) { if (wr == 0) PG8_BAR; }
    PG8_BAR;
    if constexpr (Epi::AFTER_DRAIN) E.fused(acc, cur, wr, wc, fr, fq, lds, wid, lane);
#undef PG8_SA
#undef PG8_SB
#undef PG8_STAGE
#undef PG8_LDA
#undef PG8_LDB
#undef PG8_MMA
#undef PG8_WAIT_V
#undef PG8_WAIT_L
#undef PG8_BAR
#undef PG8_SCHED
}

struct EpiProj {
    static constexpr bool PERM = true, AFTER_DRAIN = false, KEEP_ACC = false;
    bf16_t* O; const float* bgate;
    DI void operator()(const Acc& acc, const Unit& u, int wr, int wc, int fr, int fq) const {
        const int row0 = u.pm * BM + wr * 64 + fr, col0 = u.pn * BM + wc * 32 + 8 * fq;
        const bool gate = u.pn >= (C_G / 256);
        f32x4 bv[2][2];
#pragma unroll
        for (int bj = 0; bj < 2; ++bj)
#pragma unroll
            for (int n = 0; n < 2; ++n) bv[bj][n] = gate ? *(const f32x4*)(bgate + (col0 - C_G) + bj * HALF + 4 * n) : (f32x4){0.f, 0.f, 0.f, 0.f};
#pragma unroll
        for (int ai = 0; ai < 2; ++ai)
#pragma unroll
            for (int m = 0; m < 4; ++m) { bf16_t* rowp = O + (size_t)(row0 + ai * HALF + m * 16) * INW + col0;
#pragma unroll
                for (int bj = 0; bj < 2; ++bj) { f32x4 v0 = acc[ai][bj][m][0] + bv[bj][0], v1 = acc[ai][bj][m][1] + bv[bj][1];
                    if (gate) {
#pragma unroll
                        for (int e = 0; e < 4; ++e) { v0[e] = frcp(1.f + fexp2(-v0[e] * LOG2E)); v1[e] = frcp(1.f + fexp2(-v1[e] * LOG2E)); } }
                    u32x4 w; w.x = pk2(v0[0], v0[1]); w.y = pk2(v0[2], v0[3]); w.z = pk2(v1[0], v1[1]); w.w = pk2(v1[2], v1[3]);
                    *(u32x4*)(rowp + bj * HALF) = w; } }
    }
};
struct EpiBf16 {
    static constexpr bool PERM = true, AFTER_DRAIN = false, KEEP_ACC = false;
    bf16_t* O; int ldc;
    DI void operator()(const Acc& acc, const Unit& u, int wr, int wc, int fr, int fq) const {
        const int row0 = u.pm * BM + wr * 64 + fr, col0 = u.pn * BM + wc * 32 + 8 * fq;
#pragma unroll
        for (int ai = 0; ai < 2; ++ai)
#pragma unroll
            for (int m = 0; m < 4; ++m) { bf16_t* rowp = O + (size_t)(row0 + ai * HALF + m * 16) * ldc + col0;
#pragma unroll
                for (int bj = 0; bj < 2; ++bj) { const f32x4 v0 = acc[ai][bj][m][0], v1 = acc[ai][bj][m][1];
                    u32x4 w; w.x = pk2(v0[0], v0[1]); w.y = pk2(v0[2], v0[3]); w.z = pk2(v1[0], v1[1]); w.w = pk2(v1[2], v1[3]);
                    *(u32x4*)(rowp + bj * HALF) = w; } }
    }
};
struct EpiF32 {
    static constexpr bool PERM = false, AFTER_DRAIN = false, KEEP_ACC = false;
    float* O;
    DI void operator()(const Acc& acc, const Unit& u, int wr, int wc, int fr, int fq) const {
        const int row0 = u.pm * BM + wr * 64 + fr, col0 = u.pn * BM + wc * 32 + 4 * fq;
#pragma unroll
        for (int ai = 0; ai < 2; ++ai)
#pragma unroll
            for (int m = 0; m < 4; ++m) { float* rowp = O + (size_t)(row0 + ai * HALF + m * 16) * DM + col0;
#pragma unroll
                for (int bj = 0; bj < 2; ++bj)
#pragma unroll
                    for (int n = 0; n < 2; ++n) *(f32x4*)(rowp + bj * HALF + n * 16) = acc[ai][bj][m][n]; }
    }
};
DI float dpp_shr1(float oldv, float src) { return __builtin_bit_cast(float, __builtin_amdgcn_update_dpp(__builtin_bit_cast(int, oldv), __builtin_bit_cast(int, src), 0x111, 0xf, 0xf, false)); }
DI float dpp_shr2(float oldv, float src) { return __builtin_bit_cast(float, __builtin_amdgcn_update_dpp(__builtin_bit_cast(int, oldv), __builtin_bit_cast(int, src), 0x112, 0xf, 0xf, false)); }
DI float dpp_ror1(float src) { return __builtin_bit_cast(float, __builtin_amdgcn_update_dpp(0, __builtin_bit_cast(int, src), 0x121, 0xf, 0xf, false)); }
DI float dpp_ror2(float src) { return __builtin_bit_cast(float, __builtin_amdgcn_update_dpp(0, __builtin_bit_cast(int, src), 0x122, 0xf, 0xf, false)); }
DI float gelu_t(float x) { const float z = 1.5957691216057308f * (x + 0.044715f * x * x * x); return x * frcp(1.f + fexp2(-z * LOG2E)); }
struct EpiUpConv {
    static constexpr bool PERM = true, AFTER_DRAIN = false, KEEP_ACC = false;
    bf16_t* ACT; float* RAW; const float* cw; const float* cb;
    DI void operator()(const Acc& acc, const Unit& u, int wr, int wc, int fr, int fq) const {
        const int ch0 = u.pn * HALF + wc * 32 + 8 * fq;
        const int ic0 = u.pn * BM + wc * 32 + 8 * fq;
#pragma unroll
        for (int n = 0; n < 2; ++n) {
            f32x4 wg[3], wv[3], bg, bv;
#pragma unroll
            for (int k = 0; k < 3; ++k) { wg[k] = *(const f32x4*)(cw + k * UPW + ch0 + 4 * n); wv[k] = *(const f32x4*)(cw + k * UPW + DFF + ch0 + 4 * n); }
            bg = *(const f32x4*)(cb + ch0 + 4 * n); bv = *(const f32x4*)(cb + DFF + ch0 + 4 * n);
#pragma unroll
            for (int ai = 0; ai < 2; ++ai) {
                const int gidx = 4 * u.pm + 2 * ai + wr;
                float* rawg = RAW + (size_t)gidx * 4 * UPW + ic0 + 4 * n;
#pragma unroll
                for (int m = 0; m < 4; ++m) {
                    const f32x4 xg = acc[ai][0][m][n], xv = acc[ai][1][m][n];
                    if (m == 0 && fr < 2) { *(f32x4*)(rawg + (size_t)fr * UPW) = xg; *(f32x4*)(rawg + (size_t)fr * UPW + HALF) = xv; }
                    if (m == 3 && fr >= 14) { *(f32x4*)(rawg + (size_t)(fr - 12) * UPW) = xg; *(f32x4*)(rawg + (size_t)(fr - 12) * UPW + HALF) = xv; }
                    float res[4];
#pragma unroll
                    for (int e = 0; e < 4; ++e) {
                        float o1g = 0.f, o2g = 0.f, o1v = 0.f, o2v = 0.f;
                        if (m > 0) { o1g = dpp_ror1(acc[ai][0][m - 1][n][e]); o2g = dpp_ror2(acc[ai][0][m - 1][n][e]); o1v = dpp_ror1(acc[ai][1][m - 1][n][e]); o2v = dpp_ror2(acc[ai][1][m - 1][n][e]); }
                        const float p1g = dpp_shr1(o1g, xg[e]), p2g = dpp_shr2(o2g, xg[e]), p1v = dpp_shr1(o1v, xv[e]), p2v = dpp_shr2(o2v, xv[e]);
                        const float cgv = bg[e] + wg[0][e] * p2g + wg[1][e] * p1g + wg[2][e] * xg[e];
                        const float cvv = bv[e] + wv[0][e] * p2v + wv[1][e] * p1v + wv[2][e] * xv[e];
                        res[e] = gelu_t(cgv) * cvv;
                    }
                    u32x2 w; w.x = pk2(res[0], res[1]); w.y = pk2(res[2], res[3]);
                    *(u32x2*)(ACT + (size_t)(u.pm * BM + ai * HALF + wr * 64 + m * 16 + fr) * DFF + ch0 + 4 * n) = w;
                }
            }
        }
    }
};
struct EpiBranch {
    static constexpr bool PERM = true, AFTER_DRAIN = false, KEEP_ACC = true;
    const bf16_t* P; bf16_t* mix;
    DI void operator()(Acc& acc, const Unit& u, int wr, int wc, int fr, int fq) const {
        const int row0 = u.pm * BM + wr * 64 + fr, col0 = u.pn * BM + wc * 32 + 8 * fq;
#pragma unroll
        for (int ai = 0; ai < 2; ++ai) {
            u32x4 ga[4][2], gb[4][2];
#pragma unroll
            for (int m = 0; m < 4; ++m) { const bf16_t* gp = P + (size_t)(row0 + ai * HALF + m * 16) * INW + C_G + u.z * DM + col0;
#pragma unroll
                for (int bj = 0; bj < 2; ++bj) { ga[m][bj] = *(const u32x4*)(gp + bj * HALF); gb[m][bj] = (u.z < 2) ? *(const u32x4*)(gp + DM + bj * HALF) : ga[m][bj]; } }
#pragma unroll
            for (int m = 0; m < 4; ++m) { const size_t row = (size_t)(row0 + ai * HALF + m * 16);
#pragma unroll
                for (int bj = 0; bj < 2; ++bj) {
                    float g[8];
#pragma unroll
                    for (int e = 0; e < 4; ++e) { g[2 * e] = fmaxf(bflo(ga[m][bj][e]), 1e-6f); g[2 * e + 1] = fmaxf(bfhi(ga[m][bj][e]), 1e-6f); }
                    if (u.z < 2) {
#pragma unroll
                        for (int e = 0; e < 4; ++e) { g[2 * e] *= frcp(fmaxf(bflo(gb[m][bj][e]), 1e-6f)); g[2 * e + 1] *= frcp(fmaxf(bfhi(gb[m][bj][e]), 1e-6f)); }
#pragma unroll
                        for (int e = 0; e < 4; ++e) { acc[ai][bj][m][0][e] *= g[e]; acc[ai][bj][m][1][e] *= g[4 + e]; }
                    } else {
                        const f32x4 v0 = acc[ai][bj][m][0], v1 = acc[ai][bj][m][1];
                        u32x4 w; w.x = pk2(v0[0] * g[0], v0[1] * g[1]); w.y = pk2(v0[2] * g[2], v0[3] * g[3]); w.z = pk2(v1[0] * g[4], v1[1] * g[5]); w.w = pk2(v1[2] * g[6], v1[3] * g[7]);
                        *(u32x4*)(mix + row * DM + col0 + bj * HALF) = w;
                    }
                } }
        }
    }
};
struct RowStats {
    float* xbuf;
    unsigned* cnt;
    DI void run(const Acc& v, const Unit& u, int wr, int wc, int fr, int fq, LAS unsigned char* lds, int wid, int lane) const {
        LAS float* Pp = (LAS float*)lds;
        LAS float* S = (LAS float*)(lds + 4096);
#pragma unroll
        for (int ai = 0; ai < 2; ++ai)
#pragma unroll
            for (int m = 0; m < 4; ++m) {
                float q = 0.f;
#pragma unroll
                for (int bj = 0; bj < 2; ++bj)
#pragma unroll
                    for (int n = 0; n < 2; ++n) { const f32x4 x = v[ai][bj][m][n]; q += (x[0] * x[0] + x[1] * x[1]) + (x[2] * x[2] + x[3] * x[3]); }
                q += __shfl_xor(q, 16); q += __shfl_xor(q, 32);
                if (fq == 0) Pp[(ai * HALF + wr * 64 + m * 16 + fr) * 4 + wc] = q;
            }
        asm volatile("s_waitcnt lgkmcnt(0)" ::: "memory"); __builtin_amdgcn_s_barrier(); asm volatile("" ::: "memory");
        const int row = wid * 32 + (lane & 31);
        if (lane < 32) {
            const float t = (Pp[row * 4 + 0] + Pp[row * 4 + 1]) + (Pp[row * 4 + 2] + Pp[row * 4 + 3]);
            __hip_atomic_store(xbuf + (size_t)(u.pm * BM + row) * 8 + u.pn, t, __ATOMIC_RELAXED, __HIP_MEMORY_SCOPE_AGENT);
        }
        asm volatile("s_waitcnt vmcnt(0)" ::: "memory");
        if (lane == 0) __hip_atomic_fetch_add(cnt + 64 * u.pm, 1u, __ATOMIC_RELAXED, __HIP_MEMORY_SCOPE_AGENT);
        if (wid == 0) {
            unsigned spin = 0;
            while ((unsigned)__builtin_amdgcn_readfirstlane(__hip_atomic_load(cnt + 64 * u.pm, __ATOMIC_RELAXED, __HIP_MEMORY_SCOPE_AGENT)) < 64u) { __builtin_amdgcn_s_sleep(1); if (++spin > (1u << 22)) break; }
        }
        asm volatile("s_waitcnt vmcnt(0) lgkmcnt(0)" ::: "memory"); __builtin_amdgcn_s_barrier(); asm volatile("" ::: "memory");
        if (lane < 32) {
            const float* slot = xbuf + (size_t)(u.pm * BM + row) * 8; float t = 0.f;
#pragma unroll
            for (int k = 0; k < 8; ++k) t += __hip_atomic_load(slot + k, __ATOMIC_RELAXED, __HIP_MEMORY_SCOPE_AGENT);
            S[row] = rsqrtf(t * (1.f / DM) + EPS);
        }
        asm volatile("s_waitcnt lgkmcnt(0)" ::: "memory"); __builtin_amdgcn_s_barrier(); asm volatile("" ::: "memory");
    }
};
struct EpiNormRes {
    static constexpr bool PERM = true, AFTER_DRAIN = true, KEEP_ACC = false;
    const float* xin; float* xout; bf16_t* xn; const float* gpost; const float* gpre; RowStats st1, st2;
    DI void operator()(const Acc&, const Unit&, int, int, int, int) const {}
    DI void fused(Acc& acc, const Unit& u, int wr, int wc, int fr, int fq, LAS unsigned char* lds, int wid, int lane) const {
        const LAS float* S = (const LAS float*)(lds + 4096);
        const int col0 = u.pn * BM + wc * 32 + 8 * fq;
        f32x4 pre[4][2][2];
        LAS float* GL = (LAS float*)(lds + 8192);
        { const int t = wid * 64 + lane; if (t < 64) *(LAS f32x4*)(GL + 4 * t) = *(const f32x4*)(gpost + u.pn * BM + 4 * t); else if (t < 128 && xn) *(LAS f32x4*)(GL + 4 * t) = *(const f32x4*)(gpre + u.pn * BM + 4 * (t - 64)); }
        const int lc0 = wc * 32 + 8 * fq;
#pragma unroll
        for (int m = 0; m < 4; ++m) { const size_t off = (size_t)(u.pm * BM + wr * 64 + m * 16 + fr) * DM + col0;
#pragma unroll
            for (int bj = 0; bj < 2; ++bj)
#pragma unroll
                for (int n = 0; n < 2; ++n) pre[m][bj][n] = *(const f32x4*)(xin + off + bj * HALF + n * 4); }
        st1.run(acc, u, wr, wc, fr, fq, lds, wid, lane);
#pragma unroll
        for (int ai = 0; ai < 2; ++ai) {
            if (ai == 1) {
#pragma unroll
                for (int m = 0; m < 4; ++m) { const size_t off = (size_t)(u.pm * BM + HALF + wr * 64 + m * 16 + fr) * DM + col0;
#pragma unroll
                    for (int bj = 0; bj < 2; ++bj)
#pragma unroll
                        for (int n = 0; n < 2; ++n) pre[m][bj][n] = *(const f32x4*)(xin + off + bj * HALF + n * 4); }
            }
#pragma unroll
            for (int m = 0; m < 4; ++m) { const int r = ai * HALF + wr * 64 + m * 16 + fr; const float rs = S[r]; const size_t off = (size_t)(u.pm * BM + r) * DM + col0;
                const LAS float* gl = GL + lc0; asm volatile("" : "+v"(gl));
#pragma unroll
                for (int bj = 0; bj < 2; ++bj)
#pragma unroll
                    for (int n = 0; n < 2; ++n) { const f32x4 gv = *(const LAS f32x4*)(gl + bj * HALF + n * 4); const f32x4 o = pre[m][bj][n] + acc[ai][bj][m][n] * rs * gv; acc[ai][bj][m][n] = o; *(f32x4*)(xout + off + bj * HALF + n * 4) = o; } }
        }
        if (xn) {
            st2.run(acc, u, wr, wc, fr, fq, lds, wid, lane);
#pragma unroll
            for (int ai = 0; ai < 2; ++ai)
#pragma unroll
                for (int m = 0; m < 4; ++m) { const int r = ai * HALF + wr * 64 + m * 16 + fr; const float rs = S[r]; const size_t off = (size_t)(u.pm * BM + r) * DM + col0;
                    const LAS float* gl = GL + 256 + lc0; asm volatile("" : "+v"(gl));
#pragma unroll
                    for (int bj = 0; bj < 2; ++bj)
                        { const f32x4 g0 = *(const LAS f32x4*)(gl + bj * HALF), g1 = *(const LAS f32x4*)(gl + bj * HALF + 4); const f32x4 o0 = acc[ai][bj][m][0] * rs * g0, o1 = acc[ai][bj][m][1] * rs * g1;
                            u32x4 w; w.x = pk2(o0[0], o0[1]); w.y = pk2(o0[2], o0[3]); w.z = pk2(o1[0], o1[1]); w.w = pk2(o1[2], o1[3]); *(u32x4*)(xn + off + bj * HALF) = w; } }
        }
    }
};
}

constexpr int KP = 144, VP = 136;
constexpr int AT_EXT = 107520, AT_SEL = 74752, AT_KM = 75776, AT_PARTS = 77824, AT_MISC = 106496;
DI f32x16 mfma32(bf16x8 a, bf16x8 b, f32x16 c) { return __builtin_amdgcn_mfma_f32_32x32x16_bf16(a, b, c, 0, 0, 0); }

template <int DV>
DI void wave_tile(const LAS unsigned char* Kl, const LAS unsigned char* Vl, const LAS float* tbp, const bf16x8 (&qf)[4], f32x16 (&o)[DV / 32], float& m, float& l,
                  int r, int h, bool near, float cadd) {
    f32x16 s[2];
#pragma unroll
    for (int kh = 0; kh < 2; ++kh) {
        f32x16 a;
#pragma unroll
        for (int i = 0; i < 16; ++i) a[i] = 0.f;
#pragma unroll
        for (int ks = 0; ks < 4; ++ks) { const bf16x8 kf = *(const LAS bf16x8*)(Kl + (32 * kh + r) * KP + (16 * ks + 8 * h) * 2); a = mfma32(kf, qf[ks], a); }
        s[kh] = a;
    }
    float mx = -INFINITY;
    if (near) {
#pragma unroll
        for (int kh = 0; kh < 2; ++kh)
#pragma unroll
            for (int i = 0; i < 16; ++i) {
                const float v = s[kh][i] * SC2 + tbp[59 - (32 * kh + (i & 3) + 8 * (i >> 2))];
                s[kh][i] = v; mx = fmaxf(mx, v);
                if ((i & 7) == 7) __builtin_amdgcn_sched_barrier(0);
            }
    } else {
#pragma unroll
        for (int kh = 0; kh < 2; ++kh)
#pragma unroll
            for (int i = 0; i < 16; ++i) mx = fmaxf(mx, s[kh][i]);
        mx = mx * SC2 + cadd;
    }
    mx = fmaxf(mx, __shfl_xor(mx, 32));
    const float mn = fmaxf(m, mx);
    const float mu = (mn == -INFINITY) ? 0.f : mn;
    if (__ballot(mn > m) != 0ull) {
        const float alpha = fexp2(m - mu);
        l *= alpha;
#pragma unroll
        for (int d = 0; d < DV / 32; ++d) o[d] *= alpha;
    }
    m = mn;
    float ps = 0.f;
    if (near) {
#pragma unroll
        for (int kh = 0; kh < 2; ++kh)
#pragma unroll
            for (int i = 0; i < 16; ++i) { const float p = fexp2(s[kh][i] - mu); s[kh][i] = p; ps += p; }
    } else {
        const float c2 = cadd - mu;
#pragma unroll
        for (int kh = 0; kh < 2; ++kh)
#pragma unroll
            for (int i = 0; i < 16; ++i) { const float p = fexp2(s[kh][i] * SC2 + c2); s[kh][i] = p; ps += p; }
    }
    l += ps;
#pragma unroll
    for (int kh = 0; kh < 2; ++kh)
#pragma unroll
        for (int st = 0; st < 2; ++st) {
            u32x4 pw; pw.x = pk2(s[kh][8 * st + 0], s[kh][8 * st + 1]); pw.y = pk2(s[kh][8 * st + 2], s[kh][8 * st + 3]);
            pw.z = pk2(s[kh][8 * st + 4], s[kh][8 * st + 5]); pw.w = pk2(s[kh][8 * st + 6], s[kh][8 * st + 7]);
            const bf16x8 pf = __builtin_bit_cast(bf16x8, pw);
#pragma unroll
            for (int d = 0; d < DV / 32; ++d) {
                const LAS unsigned char* vp = Vl + (32 * d + r) * VP + (32 * kh + 16 * st + 4 * h) * 2;
                const s16x4 lo = *(const LAS s16x4*)vp, hi4 = *(const LAS s16x4*)(vp + 16);
                const bf16x8 vf = __builtin_shufflevector(lo, hi4, 0, 1, 2, 3, 4, 5, 6, 7);
                o[d] = mfma32(vf, pf, o[d]);
            }
            __builtin_amdgcn_sched_barrier(0);
        }
}

struct AttnCtx {
    const bf16_t* Pp; bf16_t* Yp; const float* tabp;
    const float *lq1, *lk1, *lq2, *lk2, *subg, *sinks;
    float lam_init;
};

template <int KIND>
ATTN_INL void attn_unit(int tid, LAS unsigned char* lds, const AttnCtx& C, int b, int hd, int blk) {
    constexpr int DV = KIND == 0 ? 128 : 64, NKB = KIND == 0 ? 2 : 1, NV = DV / 64;
    constexpr int KBB = 64 * KP, STG = NKB * KBB + DV * VP;
    const int lane = tid & 63, r = lane & 31, h = lane >> 5, w = __builtin_amdgcn_readfirstlane(tid >> 6);
    const size_t tokb = (size_t)b * SEQ;
    const bf16_t* Pb = C.Pp + tokb * INW;
    LAS float* ext = (LAS float*)(lds + AT_EXT);
    int qcol, kcol, vcol, ycol, bh, q0, qw0, t0, t1, kbsel = 0;
    if (KIND == 0) { const int mp = w >> 2; qcol = C_QA + hd * 128 + mp * 64; kcol = C_KA + hd * 128; vcol = C_VA + hd * 128; ycol = hd * 128; bh = hd; q0 = blk * 128; qw0 = q0 + 32 * (w & 3); t0 = 0; t1 = 2 * (blk + 1); kbsel = mp; }
    else if (KIND == 1) { qcol = C_QB + hd * 64; kcol = C_KB + (hd >> 2) * 64; vcol = C_VB + (hd >> 2) * 64; ycol = 512 + hd * 64; bh = 4 + hd; q0 = blk * 256; qw0 = q0 + 32 * w; t0 = (q0 >= 128 ? q0 - 128 : 0) / 64; t1 = (q0 + 256) / 64; }
    else { qcol = C_QC + hd * 64; kcol = C_KC + hd * 64; vcol = C_VC + hd * 64; ycol = 1024 + hd * 64; bh = 12 + hd; q0 = blk * 256; qw0 = q0 + 32 * w; t0 = 0; t1 = 4 * (blk + 1); }

    bf16x8 qf[4];
    { const bf16_t* qp = Pb + (size_t)(qw0 + r) * INW + qcol + 8 * h;
#pragma unroll
      for (int ks = 0; ks < 4; ++ks) qf[ks] = *(const bf16x8*)(qp + 16 * ks); }
    __syncthreads();
    if (tid < 320) { const int dist = tid - 96; const int di = dist < 0 ? 0 : (dist > 128 ? 128 : dist);
        const float tv = C.tabp[bh * TABN + di];
        ext[tid] = (dist < 0 || (KIND == 1 && dist >= 128)) ? -INFINITY : tv; ext[320 + tid] = -INFINITY; }
    unsigned selmask = 0xffu;
    if (KIND == 2) {
        const int ob = blk;
        LAS float* parts = (LAS float*)(lds + AT_PARTS);
        LAS float* km = (LAS float*)(lds + AT_KM);
        LAS unsigned char* sel = lds + AT_SEL;
        {
            const int d2 = tid & 31, kp = tid >> 5;
            for (int j = 0; j < ob; j += 2) {
                const bf16_t* kb = Pb + (size_t)(j * 256 + kp * 16) * INW + kcol + 2 * d2;
                const bool two = j + 1 < ob;
                unsigned wa[16], wb[16];
#pragma unroll
                for (int k = 0; k < 16; ++k) { wa[k] = *(const unsigned*)(kb + (size_t)k * INW); wb[k] = two ? *(const unsigned*)(kb + (size_t)(256 + k) * INW) : 0u; }
                float s0 = 0.f, s1 = 0.f, t0 = 0.f, t1 = 0.f;
#pragma unroll
                for (int k = 0; k < 16; ++k) { s0 += bflo(wa[k]); s1 += bfhi(wa[k]); t0 += bflo(wb[k]); t1 += bfhi(wb[k]); }
                parts[(j * 16 + kp) * 64 + 2 * d2] = s0; parts[(j * 16 + kp) * 64 + 2 * d2 + 1] = s1;
                if (two) { parts[((j + 1) * 16 + kp) * 64 + 2 * d2] = t0; parts[((j + 1) * 16 + kp) * 64 + 2 * d2 + 1] = t1; }
            }
        }
        __syncthreads();
        if (tid < ob * 64) { const int j = tid >> 6, d = tid & 63; float s = 0.f;
#pragma unroll
            for (int k = 0; k < 16; ++k) s += parts[(j * 16 + k) * 64 + d];
            km[j * 64 + d] = s * (1.f / 256.f); }
        __syncthreads();
        {
            const int qi = tid >> 1, hf = tid & 1;
            const bf16_t* qp = Pb + (size_t)(q0 + qi) * INW + qcol + 32 * hf;
            float qv[32];
#pragma unroll
            for (int c = 0; c < 4; ++c) { const u32x4 wv = *(const u32x4*)(qp + 8 * c);
                qv[8 * c + 0] = bflo(wv.x); qv[8 * c + 1] = bfhi(wv.x); qv[8 * c + 2] = bflo(wv.y); qv[8 * c + 3] = bfhi(wv.y);
                qv[8 * c + 4] = bflo(wv.z); qv[8 * c + 5] = bfhi(wv.z); qv[8 * c + 6] = bflo(wv.w); qv[8 * c + 7] = bfhi(wv.w); }
            float gt[7];
#pragma unroll
            for (int j = 0; j < 7; ++j) { float s = 0.f;
                if (j < ob) {
#pragma unroll
                    for (int d = 0; d < 32; ++d) s += qv[d] * km[j * 64 + 32 * hf + d]; }
                s += __shfl_xor(s, 1); gt[j] = s; }
            unsigned msk = 0;
#pragma unroll
            for (int j = 0; j < 7; ++j) { int rank = 0;
#pragma unroll
                for (int i = 0; i < 7; ++i) if (i != j && i < ob) rank += (gt[i] > gt[j] || (gt[i] == gt[j] && i < j)) ? 1 : 0;
                if (j < ob && rank < 3) msk |= 1u << j; }
            if (hf == 0) sel[qi] = (unsigned char)msk;
        }
        __syncthreads();
        selmask = sel[32 * w + r];
    }
    asm volatile("" : "+v"(qf[0]), "+v"(qf[1]), "+v"(qf[2]), "+v"(qf[3]));
    f32x16 o[DV / 32];
#pragma unroll
    for (int d = 0; d < DV / 32; ++d)
#pragma unroll
        for (int i = 0; i < 16; ++i) o[d][i] = 0.f;
    float mrun = -INFINITY, lrun = 0.f;
    const int skey = tid >> 3, sc = tid & 7;
    const int vkey = tid & 63, vc0 = tid >> 6;
    u32x4 kreg[NKB], vreg[NV];
#define AT_LOAD(t) do { const bf16_t* kb_ = Pb + (size_t)((t) * 64 + skey) * INW + kcol + 8 * sc; \
        _Pragma("unroll") for (int nb = 0; nb < NKB; ++nb) kreg[nb] = *(const u32x4*)(kb_ + 64 * nb); \
        const bf16_t* vb_ = Pb + (size_t)((t) * 64 + vkey) * INW + vcol + 8 * vc0; \
        _Pragma("unroll") for (int i = 0; i < NV; ++i) vreg[i] = *(const u32x4*)(vb_ + 64 * i); } while (0)
#define AT_STORE(stg) do { LAS unsigned char* sb_ = lds + (stg) * STG; \
        _Pragma("unroll") for (int nb = 0; nb < NKB; ++nb) *(LAS u32x4*)(sb_ + nb * KBB + skey * KP + 16 * sc) = kreg[nb]; \
        _Pragma("unroll") for (int i = 0; i < NV; ++i) { LAS unsigned char* vt_ = sb_ + NKB * KBB + (8 * (vc0 + 8 * i)) * VP + 2 * vkey; \
            *(LAS unsigned short*)(vt_ + 0 * VP) = (unsigned short)(vreg[i].x & 0xffffu); *(LAS unsigned short*)(vt_ + 1 * VP) = (unsigned short)(vreg[i].x >> 16); \
            *(LAS unsigned short*)(vt_ + 2 * VP) = (unsigned short)(vreg[i].y & 0xffffu); *(LAS unsigned short*)(vt_ + 3 * VP) = (unsigned short)(vreg[i].y >> 16); \
            *(LAS unsigned short*)(vt_ + 4 * VP) = (unsigned short)(vreg[i].z & 0xffffu); *(LAS unsigned short*)(vt_ + 5 * VP) = (unsigned short)(vreg[i].z >> 16); \
            *(LAS unsigned short*)(vt_ + 6 * VP) = (unsigned short)(vreg[i].w & 0xffffu); *(LAS unsigned short*)(vt_ + 7 * VP) = (unsigned short)(vreg[i].w >> 16); } } while (0)
    AT_LOAD(t0); AT_STORE(0);
    __syncthreads();
    const float cfar = ext[96 + 128];
    for (int t = t0; t < t1; ++t) {
        const int stg = (t - t0) & 1;
        if (t + 1 < t1) AT_LOAD(t + 1);
        {
            const int key0 = t * 64;
            bool skip, near, lv = true;
            if (KIND == 0) { skip = key0 > qw0 + 31; near = key0 > qw0 - 191; }
            else if (KIND == 1) { skip = (key0 > qw0 + 31) || (key0 + 63 < qw0 - 127); near = true; }
            else { if (t < 4 * blk) { lv = (selmask >> (t >> 2)) & 1u; skip = __ballot(lv) == 0ull; near = key0 > qw0 - 191; } else { skip = key0 > qw0 + 31; near = key0 > qw0 - 191; } }
            if (!skip) {
                const LAS unsigned char* sb = lds + stg * STG;
                const LAS float* tbp = ext + (lv ? 0 : 320) + (qw0 + r - key0 - 4 * h + 96 - 59);
                wave_tile<DV>(sb + kbsel * KBB, sb + NKB * KBB, tbp, qf, o, mrun, lrun, r, h, near, lv ? cfar : -INFINITY);
            }
        }
        if (t + 1 < t1) AT_STORE(stg ^ 1);
        __syncthreads();
    }
#undef AT_LOAD
#undef AT_STORE
    float ltot = lrun + __shfl_xor(lrun, 32);
    if (KIND == 1) ltot += fexp2(C.sinks[hd] * LOG2E - mrun);
    const float inv = 1.f / ltot;
    bf16_t* yrow = C.Yp + (tokb + qw0 + r) * YW + ycol;
    if (KIND != 0) {
#pragma unroll
        for (int d = 0; d < 2; ++d)
#pragma unroll
            for (int g = 0; g < 4; ++g) { u32x2 wv; wv.x = pk2(o[d][4 * g] * inv, o[d][4 * g + 1] * inv); wv.y = pk2(o[d][4 * g + 2] * inv, o[d][4 * g + 3] * inv);
                *(u32x2*)(yrow + 32 * d + 8 * g + 4 * h) = wv; }
    } else {
        const float s1 = wave_sum(C.lq1[lane] * C.lk1[lane]), s2 = wave_sum(C.lq2[lane] * C.lk2[lane]);
        const float lam = __expf(s1) - __expf(s2) + C.lam_init;
        LAS float* X = (LAS float*)lds;
        const int qi = 32 * (w & 3) + r;
        if (w >= 4) {
#pragma unroll
            for (int d = 0; d < 4; ++d)
#pragma unroll
                for (int g = 0; g < 4; ++g) *(LAS f32x4*)(X + qi * 132 + 32 * d + 8 * g + 4 * h) = (f32x4){o[d][4 * g] * inv, o[d][4 * g + 1] * inv, o[d][4 * g + 2] * inv, o[d][4 * g + 3] * inv};
        }
        __syncthreads();
        if (w < 4) {
            float ss = 0.f;
#pragma unroll
            for (int d = 0; d < 4; ++d)
#pragma unroll
                for (int g = 0; g < 4; ++g) { const f32x4 o2 = *(const LAS f32x4*)(X + qi * 132 + 32 * d + 8 * g + 4 * h);
#pragma unroll
                    for (int e = 0; e < 4; ++e) { const float v = o[d][4 * g + e] * inv - lam * o2[e]; o[d][4 * g + e] = v; ss += v * v; } }
            ss += __shfl_xor(ss, 32);
            const float rs = rsqrtf(ss * (1.f / 128.f) + EPS) * (1.f - C.lam_init);
#pragma unroll
            for (int d = 0; d < 4; ++d)
#pragma unroll
                for (int g = 0; g < 4; ++g) { const int dc = 32 * d + 8 * g + 4 * h; const f32x4 gg = *(const f32x4*)(C.subg + dc);
                    u32x2 wv; wv.x = pk2(o[d][4 * g] * rs * gg[0], o[d][4 * g + 1] * rs * gg[1]); wv.y = pk2(o[d][4 * g + 2] * rs * gg[2], o[d][4 * g + 3] * rs * gg[3]);
                    *(u32x2*)(yrow + dc) = wv; }
        }
    }
}

DI void attn_phase(int tid, LAS unsigned char* lds, const AttnCtx& C, unsigned* ctr, int kindsel) {
    LAS int* nxt = (LAS int*)(lds + AT_MISC);
    for (;;) {
        __syncthreads();
        if (tid == 0) nxt[0] = (int)atomicAdd(ctr, 1u);
        __syncthreads();
        const int i = __builtin_amdgcn_readfirstlane(nxt[0]);
        if (i >= 768) break;
        int tl = tid; asm volatile("" : "+v"(tl));
        if (i < 512) {
            const int g = i >> 6, j = i & 63;
            int bb, hh, kk;
            if (j < 16) { bb = j >> 2; hh = j & 3; kk = 15 - 2 * g; } else if (j >= 48) { bb = (j - 48) >> 2; hh = (j - 48) & 3; kk = 14 - 2 * g; } else { bb = (j - 16) >> 3; hh = (j - 16) & 7; kk = 7 - g; }
            if (j < 16 || j >= 48) { if (kindsel & 1) attn_unit<0>(tl, lds, C, bb, hh, kk); }
            else { if (kindsel & 4) attn_unit<2>(tl, lds, C, bb, hh, kk); }
        } else {
            const int j = i - 512; if (kindsel & 2) attn_unit<1>(tl, lds, C, j >> 6, (j >> 3) & 7, j & 7);
        }
    }
}

DI void row_phase(int gw, int NGW, int lane, const float* xin, const float* y, const float* gpost, const float* gpre, float* xout, bf16_t* xn) {
    for (int m = gw; m < M; m += NGW) {
        const f32x4* xr = (const f32x4*)(xin + (size_t)m * DM) + lane;
        f32x4 v[8];
#pragma unroll
        for (int j = 0; j < 8; ++j) v[j] = xr[64 * j];
        if (y) {
            const f32x4* yr = (const f32x4*)(y + (size_t)m * DM) + lane;
            f32x4 wv[8]; float ss = 0.f;
#pragma unroll
            for (int j = 0; j < 8; ++j) { wv[j] = yr[64 * j]; ss += (wv[j][0] * wv[j][0] + wv[j][1] * wv[j][1]) + (wv[j][2] * wv[j][2] + wv[j][3] * wv[j][3]); }
            const float rs = rsqrtf(wave_sum(ss) * (1.f / DM) + EPS);
            f32x4* xo = (f32x4*)(xout + (size_t)m * DM) + lane;
#pragma unroll
            for (int j = 0; j < 8; ++j) { const f32x4 gp = ((const f32x4*)gpost)[lane + 64 * j]; v[j] += wv[j] * rs * gp; xo[64 * j] = v[j]; }
        }
        if (xn) {
            float ss = 0.f;
#pragma unroll
            for (int j = 0; j < 8; ++j) ss += (v[j][0] * v[j][0] + v[j][1] * v[j][1]) + (v[j][2] * v[j][2] + v[j][3] * v[j][3]);
            const float rs = rsqrtf(wave_sum(ss) * (1.f / DM) + EPS);
            u32x2* xo = (u32x2*)(xn + (size_t)m * DM) + lane;
#pragma unroll
            for (int j = 0; j < 8; ++j) { const f32x4 gp = ((const f32x4*)gpre)[lane + 64 * j]; const f32x4 t = v[j] * rs * gp;
                u32x2 wv; wv.x = pk2(t[0], t[1]); wv.y = pk2(t[2], t[3]); xo[64 * j] = wv; }
        }
    }
}
DI float gelu_tanh(float x) {
    const float z = 1.5957691216057308f * (x + 0.044715f * x * x * x);
    return x * frcp(1.f + fexp2(-z * LOG2E));
}
DI void conv_phase(int gt, int NGT, const bf16_t* U, const float* cw, const float* cb, bf16_t* ACT) {
    constexpr int NCG = DFF / 8, NRC = M / 16;
    for (int it = gt; it < NRC * NCG; it += NGT) {
        const int cgp = it % NCG, rc = it / NCG, tt0 = rc * 16, j0 = cgp * 8;
        float wg[3][8], wv[3][8], bg[8], bvl[8];
#pragma unroll
        for (int k = 0; k < 3; ++k)
#pragma unroll
            for (int e = 0; e < 8; e += 4) { const f32x4 a = *(const f32x4*)(cw + k * UPW + j0 + e), c = *(const f32x4*)(cw + k * UPW + DFF + j0 + e);
#pragma unroll
                for (int q = 0; q < 4; ++q) { wg[k][e + q] = a[q]; wv[k][e + q] = c[q]; } }
#pragma unroll
        for (int e = 0; e < 8; e += 4) { const f32x4 a = *(const f32x4*)(cb + j0 + e), c = *(const f32x4*)(cb + DFF + j0 + e);
#pragma unroll
            for (int q = 0; q < 4; ++q) { bg[e + q] = a[q]; bvl[e + q] = c[q]; } }
        const bf16_t* ug = U + (size_t)tt0 * UPW + j0;
        u32x4 g2 = {0, 0, 0, 0}, g1 = g2, v2 = g2, v1 = g2;
        if ((tt0 & (SEQ - 1)) != 0) { g2 = *(const u32x4*)(ug - 2 * (size_t)UPW); g1 = *(const u32x4*)(ug - (size_t)UPW); v2 = *(const u32x4*)(ug - 2 * (size_t)UPW + DFF); v1 = *(const u32x4*)(ug - (size_t)UPW + DFF); }
#pragma unroll 4
        for (int rr = 0; rr < 16; ++rr) {
            const u32x4 g0 = *(const u32x4*)(ug + (size_t)rr * UPW), v0 = *(const u32x4*)(ug + (size_t)rr * UPW + DFF);
            float res[8];
#pragma unroll
            for (int e = 0; e < 4; ++e) {
                const float a0 = bg[2 * e] + wg[0][2 * e] * bflo(g2[e]) + wg[1][2 * e] * bflo(g1[e]) + wg[2][2 * e] * bflo(g0[e]);
                const float a1 = bg[2 * e + 1] + wg[0][2 * e + 1] * bfhi(g2[e]) + wg[1][2 * e + 1] * bfhi(g1[e]) + wg[2][2 * e + 1] * bfhi(g0[e]);
                const float c0 = bvl[2 * e] + wv[0][2 * e] * bflo(v2[e]) + wv[1][2 * e] * bflo(v1[e]) + wv[2][2 * e] * bflo(v0[e]);
                const float c1 = bvl[2 * e + 1] + wv[0][2 * e + 1] * bfhi(v2[e]) + wv[1][2 * e + 1] * bfhi(v1[e]) + wv[2][2 * e + 1] * bfhi(v0[e]);
                res[2 * e] = gelu_tanh(a0) * c0; res[2 * e + 1] = gelu_tanh(a1) * c1;
            }
            u32x4 ow; ow.x = pk2(res[0], res[1]); ow.y = pk2(res[2], res[3]); ow.z = pk2(res[4], res[5]); ow.w = pk2(res[6], res[7]);
            *(u32x4*)(ACT + (size_t)(tt0 + rr) * DFF + j0) = ow;
            g2 = g1; g1 = g0; v2 = v1; v1 = v0;
        }
    }
}

DI void conv_fix_phase(int gt, int NGT, const float* RAW, const float* cw, const float* cb, bf16_t* ACT) {
    constexpr int NC4 = DFF / 4;
    for (int it = gt; it < (M / 64) * 2 * NC4; it += NGT) {
        const int c4 = it % NC4, rr = (it / NC4) & 1, gidx = it / (2 * NC4), j0 = 4 * c4, ic = 256 * (j0 >> 7) + (j0 & 127);
        const bool hasprev = (gidx & 31) != 0;
        const float* own = RAW + (size_t)gidx * 4 * UPW + ic; const float* prv = own - (size_t)4 * UPW;
        const f32x4 z4 = {0.f, 0.f, 0.f, 0.f};
        f32x4 x0g, x1g, x2g, x0v, x1v, x2v;
        x0g = *(const f32x4*)(own + (size_t)rr * UPW); x0v = *(const f32x4*)(own + (size_t)rr * UPW + 128);
        if (rr) { x1g = *(const f32x4*)(own); x1v = *(const f32x4*)(own + 128); x2g = hasprev ? *(const f32x4*)(prv + (size_t)3 * UPW) : z4; x2v = hasprev ? *(const f32x4*)(prv + (size_t)3 * UPW + 128) : z4; }
        else { x1g = hasprev ? *(const f32x4*)(prv + (size_t)3 * UPW) : z4; x1v = hasprev ? *(const f32x4*)(prv + (size_t)3 * UPW + 128) : z4;
               x2g = hasprev ? *(const f32x4*)(prv + (size_t)2 * UPW) : z4; x2v = hasprev ? *(const f32x4*)(prv + (size_t)2 * UPW + 128) : z4; }
        float res[4];
        const f32x4 bg = *(const f32x4*)(cb + j0), bv = *(const f32x4*)(cb + DFF + j0);
        const f32x4 w0g = *(const f32x4*)(cw + j0), w1g = *(const f32x4*)(cw + UPW + j0), w2g = *(const f32x4*)(cw + 2 * UPW + j0);
        const f32x4 w0v = *(const f32x4*)(cw + DFF + j0), w1v = *(const f32x4*)(cw + UPW + DFF + j0), w2v = *(const f32x4*)(cw + 2 * UPW + DFF + j0);
#pragma unroll
        for (int e = 0; e < 4; ++e) { const float cgv = bg[e] + w0g[e] * x2g[e] + w1g[e] * x1g[e] + w2g[e] * x0g[e], cvv = bv[e] + w0v[e] * x2v[e] + w1v[e] * x1v[e] + w2v[e] * x0v[e];
            res[e] = pg8::gelu_t(cgv) * cvv; }
        u32x2 w; w.x = pk2(res[0], res[1]); w.y = pk2(res[2], res[3]);
        *(u32x2*)(ACT + (size_t)(gidx * 64 + rr) * DFF + j0) = w;
    }
}

template <bool UPMAP = false>
DI void transpose_item(const float* W, int K, int N, bf16_t* WT, LAS float* scr, int item, int lane) {
    const int nblk = N / 32, kb = item / nblk, nb = item % nblk, k0 = 64 * kb, n0 = 32 * nb;
    int r0 = n0;
    if (UPMAP) { const int j = n0 >= DFF ? n0 - DFF : n0; r0 = 256 * (j >> 7) + (j & 127) + (n0 >= DFF ? 128 : 0); }
    float v[32];
    const float* src = W + (size_t)(k0 + (lane >> 5)) * N + n0 + (lane & 31);
#pragma unroll
    for (int i = 0; i < 32; ++i) v[i] = src[(size_t)(2 * i) * N];
#pragma unroll
    for (int i = 0; i < 32; ++i) scr[(2 * i + (lane >> 5)) * 33 + (lane & 31)] = v[i];
    asm volatile("s_waitcnt lgkmcnt(0)" ::: "memory");
    const int c = lane & 7;
#pragma unroll
    for (int j = 0; j < 4; ++j) { const int n = (lane >> 3) + 8 * j; const LAS float* s = scr + (8 * c) * 33 + n;
        u32x4 o; o.x = pk2(s[0 * 33], s[1 * 33]); o.y = pk2(s[2 * 33], s[3 * 33]); o.z = pk2(s[4 * 33], s[5 * 33]); o.w = pk2(s[6 * 33], s[7 * 33]);
        *(u32x4*)(WT + (size_t)(r0 + n) * K + k0 + 8 * c) = o; }
    asm volatile("s_waitcnt lgkmcnt(0)" ::: "memory");
}

#define XB_TMO      128
#define XB_XCNT(j)  (256  + 64 * (j))
#define XB_XSUB(j)  (1280 + 64 * (j))
#define XB_XGEN(j)  (2304 + 64 * (j))
#define XB_TOP      3328
#define XB_TOPGEN   3392
#define XCD_BAR_WORDS 3456
#define XB_SPIN_CAP (1u << 22)
constexpr int CW_BAR = 4096;
DI unsigned xb_ld(unsigned* p)              { return __hip_atomic_load(p, __ATOMIC_RELAXED, __HIP_MEMORY_SCOPE_AGENT); }
DI unsigned xb_add(unsigned* p, unsigned v) { return __hip_atomic_fetch_add(p, v, __ATOMIC_RELAXED, __HIP_MEMORY_SCOPE_AGENT); }
DI unsigned xb_xcc_id() { return (unsigned)__builtin_amdgcn_s_getreg((3 << 11) | 20) & 0xFu; }
#define XB_SPIN(cond, bar) do { unsigned _sp = 0; while (cond) { __builtin_amdgcn_s_sleep(1); \
    if ((++_sp & 255u) == 0u) { if (xb_ld(&(bar)[XB_TMO])) break; if (_sp > XB_SPIN_CAP) { atomicAdd(&(bar)[XB_TMO], 1u); break; } } } } while (0)
struct XcdBarrier { unsigned* bar; unsigned x; volatile LAS unsigned* st; };
DI XcdBarrier xcd_barrier_post(unsigned* bar, volatile LAS unsigned* st) {
    XcdBarrier b; b.bar = bar; b.x = xb_xcc_id(); b.st = st;
    if (threadIdx.x == 0) (void)xb_add(&bar[XB_XCNT(b.x)], 1u);
    return b;
}
DI void xcd_barrier_complete(unsigned* bar, unsigned x, unsigned& nloc, unsigned& nx) {
    const unsigned G = gridDim.x * gridDim.y * gridDim.z;
    unsigned sum, cnt, mine, sp = 0u;
    for (;;) {
        sum = 0u; cnt = 0u; mine = 0u;
#pragma unroll
        for (unsigned j = 0; j < 16; ++j) { const unsigned c = xb_ld(&bar[XB_XCNT(j)]); sum += c; cnt += (c > 0u) ? 1u : 0u; mine = (j == x) ? c : mine; }
        if (sum == G) break;
        __builtin_amdgcn_s_sleep(1);
        if ((++sp & 255u) == 0u) { if (xb_ld(&bar[XB_TMO])) break; if (sp > XB_SPIN_CAP) { atomicAdd(&bar[XB_TMO], 1u); break; } }
    }
    nloc = mine > 0u ? mine : 1u; nx = cnt > 0u ? cnt : 1u;
}
DI void xcd_barrier(const XcdBarrier& b) {
    asm volatile("s_waitcnt vmcnt(0)" ::: "memory");
    __syncthreads();
    if (threadIdx.x == 0) {
        unsigned* bar = b.bar;
        __builtin_amdgcn_s_waitcnt(0);
        unsigned nloc = b.st[0], nx = b.st[1];
        if (nloc == 0u) { xcd_barrier_complete(bar, b.x, nloc, nx); b.st[0] = nloc; b.st[1] = nx; }
        const unsigned old = xb_add(&bar[XB_XSUB(b.x)], 1u);
        const unsigned gen = old / nloc;
        if (old + 1u == (gen + 1u) * nloc) {
            __builtin_amdgcn_fence(__ATOMIC_RELEASE, "agent");
            asm volatile("s_waitcnt vmcnt(0)" ::: "memory");
            const unsigned og = xb_add(&bar[XB_TOP], 1u);
            const unsigned tg = og / nx;
            if (og + 1u == (tg + 1u) * nx) xb_add(&bar[XB_TOPGEN], 1u);
            else XB_SPIN(xb_ld(&bar[XB_TOPGEN]) == tg, bar);
            __builtin_amdgcn_fence(__ATOMIC_ACQUIRE, "agent");
            xb_add(&bar[XB_XGEN(b.x)], 1u);
            asm volatile("s_waitcnt vmcnt(0)" ::: "memory");
        } else {
            XB_SPIN(xb_ld(&bar[XB_XGEN(b.x)]) == gen, bar);
            __builtin_amdgcn_fence(__ATOMIC_ACQUIRE, "agent");
            asm volatile("s_waitcnt vmcnt(0)" ::: "memory");
        }
    }
    __syncthreads();
}

struct Args { const float* in[22]; float* out; unsigned char* ws; int ph_lo, ph_hi; };
#ifndef PROBE_SP
#define PROBE_SP (-1)
#endif
constexpr int SLOTS = 9 + (PROBE_SP >= 0 ? 1 : 0), N_PHASES = 1 + SLOTS * DEPTH;

__global__ void __launch_bounds__(512, 2) fwd_kernel(Args args) {
    extern __shared__ __attribute__((aligned(16))) unsigned char lds_raw[];
    LAS unsigned char* lds = (LAS unsigned char*)lds_raw;
    cg::grid_group grid = cg::this_grid();
    const int G = gridDim.x, bx = blockIdx.x, NGW = G * 8;
    unsigned char* ws = args.ws;
    unsigned* ctl = (unsigned*)(ws + WS_CTL);
#define tabg   ((float*)(ws + WS_TAB))
#define Win_t  ((bf16_t*)(ws + WS_WIN))
#define Wo3_t  ((bf16_t*)(ws + WS_WO3))
#define Wout_t ((bf16_t*)(ws + WS_WOUT))
#define Wup_t  ((bf16_t*)(ws + WS_WUP))
#define Wdn_t  ((bf16_t*)(ws + WS_WDN))
#define XN     ((bf16_t*)(ws + WS_XN))
#define P      ((bf16_t*)(ws + WS_P))
#define Y      ((bf16_t*)(ws + WS_Y))
#define TMP    ((float*)(ws + WS_TMP))
#define MIX    ((bf16_t*)(ws + WS_MIX))
#define U      ((bf16_t*)(ws + WS_U))
#define ACT    ((bf16_t*)(ws + WS_ACT))
    const float* x_in = args.in[0];
    float* xres = args.out;
    constexpr int I_IN = 32 * (INW / 32), I_O = 8 * 64, I_OUT = 32 * 64, I_UP = 32 * (UPW / 32), I_DN = 88 * 64, I_L = I_IN + 3 * I_O + I_OUT + I_UP + I_DN, I_DEFA = 0;
    const bool defer = (G == 256);
#define CONVERT_ITEM(l_, rI_) do { const int l__ = (l_); int r__ = (rI_); LAS float* scr__ = (LAS float*)(lds + wave * 16384); \
        if (r__ < I_IN) { transpose_item(args.in[2] + (size_t)l__ * DM * INW, DM, INW, Win_t + (size_t)l__ * INW * DM, scr__, r__, lane); break; } r__ -= I_IN; \
        if (r__ < 3 * I_O) { const int br__ = r__ / I_O; transpose_item(args.in[10 + br__] + (size_t)l__ * 512 * DM, 512, DM, Wo3_t + (size_t)(l__ * 3 + br__) * DM * 512, scr__, r__ % I_O, lane); break; } r__ -= 3 * I_O; \
        if (r__ < I_OUT) { transpose_item(args.in[13] + (size_t)l__ * DM * DM, DM, DM, Wout_t + (size_t)l__ * DM * DM, scr__, r__, lane); break; } r__ -= I_OUT; \
        if (r__ < I_UP) { transpose_item<true>(args.in[18] + (size_t)l__ * DM * UPW, DM, UPW, Wup_t + (size_t)l__ * UPW * DM, scr__, r__, lane); break; } r__ -= I_UP; \
        transpose_item(args.in[21] + (size_t)l__ * DFF * DM, DFF, DM, Wdn_t + (size_t)l__ * DM * DFF, scr__, r__, lane); } while (0)
    const bool fusedln = (G == 256);
    for (int u = threadIdx.x; u < (LDS_BYTES - 131072) / 4; u += 512) ((LAS unsigned*)(lds + 131072))[u] = 0u;
    __syncthreads();
    XcdBarrier xbar; xbar.bar = ctl + CW_BAR; xbar.x = 0; xbar.st = nullptr;
    if (args.ph_hi - args.ph_lo > 1) xbar = xcd_barrier_post(ctl + CW_BAR, (volatile LAS unsigned*)(lds + 131072 + 320) + 8);
    int nsync = 0;

#if N_LAUNCH_MODE == 1
#pragma clang loop unroll(full)
    for (int ph = 0; ph < N_PHASES; ++ph) {
#else
    for (int ph = args.ph_lo; ph < args.ph_hi; ++ph) {
#endif
      const int q_ = ph > 0 ? (ph - 1) % SLOTS : 0;
      const int l = ph > 0 ? (ph - 1) / SLOTS : 0, sp = (PROBE_SP >= 0 && q_ > PROBE_SP) ? q_ - 1 : q_;
      const int rep = (PROBE_SP >= 0 && q_ == PROBE_SP + 1) ? 1 : 0;
      if (ph > 0 && fusedln && (sp == 4 || sp == 8)) continue;
      {
        if (ph > (N_LAUNCH_MODE == 1 ? 0 : args.ph_lo)) { if (nsync == 0 || !USE_XCD_BAR) grid.sync(); else xcd_barrier(xbar); ++nsync; }
        int tid = threadIdx.x; asm volatile("" : "+v"(tid));
        const int lane = tid & 63, wave = __builtin_amdgcn_readfirstlane(tid >> 6), gw = bx * 8 + wave;
        if (ph == 0) {
#if PH_MASK & 1
            if (bx == 0) {
                for (int idx = tid; idx < 20 * 129; idx += 512) { const int hh = idx / 129, d = idx % 129; int bkt;
                    if (d < 16) bkt = d; else { bkt = 16 + (int)(logf((float)d / 16.f) / 2.0794415416798357f * 16.f); bkt = bkt > 31 ? 31 : bkt; }
                    tabg[hh * TABN + d] = args.in[1][bkt * 20 + hh] * LOG2E; }
            }
            for (int it = gw; it < DEPTH * I_L; it += NGW) {
                const int l = it / I_L, rI = it % I_L;
                if (defer && l > 0 && ((rI >= I_IN && rI < I_IN + I_DEFA) || rI >= I_L - I_DN)) continue;
                CONVERT_ITEM(l, rI);
            }
            row_phase(gw, NGW, lane, x_in, nullptr, nullptr, args.in[14], nullptr, XN);
#endif
            continue;
        }
        if (0) {}
#if PH_MASK & 2
        else if (sp == 0) {
            pg8::Gemm g{XN, Win_t + (size_t)l * INW * DM, DM, DM, DM, 0, 0}; pg8::StaticOrder S; S.init(M, INW, G, bx);
            pg8::EpiProj E{P, args.in[3] + (size_t)l * 3 * DM};
            pg8::gemm_phase<pg8::EpiProj, pg8::StaticOrder, true>(tid, lds, g, S, E);
        }
#endif
#if PH_MASK & 4
        else if (sp == 1) {
            AttnCtx C; C.Pp = P; C.Yp = Y; C.tabp = tabg; C.lq1 = args.in[4] + l * 64; C.lk1 = args.in[5] + l * 64; C.lq2 = args.in[6] + l * 64; C.lk2 = args.in[7] + l * 64;
            C.subg = args.in[8] + l * 128; C.sinks = args.in[9] + l * 8; C.lam_init = 0.8f - 0.6f * __expf(-0.3f * (float)l);
            attn_phase(tid, lds, C, ctl + 64 * (1 + l + 8 * rep), rep ? DUP_KIND : 7);
        }
#endif
#if PH_MASK & 8
        else if (sp == 2) {
            pg8::Gemm g{Y, Wo3_t + (size_t)l * 3 * DM * 512, YW, 512, 512, 512, (long)DM * 512}; pg8::BranchOrder S; S.init(M, DM, G, bx);
            pg8::EpiBranch E{P, MIX};
            pg8::gemm_phase<pg8::EpiBranch, pg8::BranchOrder, true>(tid, lds, g, S, E);
        }
#endif
#if PH_MASK & 16
        else if (sp == 3 || sp == 7) {
            pg8::Gemm g = (sp == 3) ? pg8::Gemm{MIX, Wout_t + (size_t)l * DM * DM, DM, DM, DM, 0, 0} : pg8::Gemm{ACT, Wdn_t + (size_t)l * DM * DFF, DFF, DFF, DFF, 0, 0};
            pg8::StaticOrder S; S.init(M, DM, G, bx);
            if (fusedln) {
                const int k = l * 4 + (sp == 3 ? 0 : 2); float* xb = (float*)(ws + WS_XB);
                const pg8::RowStats s1{xb + (size_t)k * M * 8, ctl + CW_SEAM + k * 2048}, s2{xb + (size_t)(k + 1) * M * 8, ctl + CW_SEAM + (k + 1) * 2048};
                const bool more = (sp == 3) || (l + 1 < DEPTH);
                pg8::EpiNormRes E{(sp == 3 && l == 0) ? x_in : xres, xres, more ? XN : nullptr, (sp == 3 ? args.in[15] : args.in[17]) + l * DM,
                                  sp == 3 ? args.in[16] + l * DM : args.in[14] + (l + 1 < DEPTH ? l + 1 : 0) * DM, s1, s2};
                pg8::gemm_phase<pg8::EpiNormRes, pg8::StaticOrder, false>(tid, lds, g, S, E);
            } else {
                pg8::EpiF32 E{TMP};
                pg8::gemm_phase<pg8::EpiF32, pg8::StaticOrder, true>(tid, lds, g, S, E);
            }
        }
#endif
#if PH_MASK & 32
        else if (sp == 4) {
            row_phase(gw, NGW, lane, l == 0 ? x_in : xres, TMP, args.in[15] + l * DM, args.in[16] + l * DM, xres, XN);
        }
#endif
#if PH_MASK & 64
        else if (sp == 5) {
            pg8::Gemm g{XN, Wup_t + (size_t)l * UPW * DM, DM, DM, DM, 0, 0}; pg8::StaticOrder S; S.init(M, UPW, G, bx);
            pg8::EpiUpConv E{ACT, (float*)U, args.in[19] + (size_t)l * 3 * UPW, args.in[20] + (size_t)l * UPW};
            pg8::gemm_phase<pg8::EpiUpConv, pg8::StaticOrder, true>(tid, lds, g, S, E);
            if (defer && l + 1 < DEPTH && bx >= 128) {
                for (int k = (bx - 128) * 8 + wave; k < I_DEFA + I_DN; k += 128 * 8) CONVERT_ITEM(l + 1, k < I_DEFA ? I_IN + k : I_L - I_DN + (k - I_DEFA));
            }
        }
#endif
#if PH_MASK & 128
        else if (sp == 6) {
            conv_fix_phase(bx * 512 + tid, G * 512, (const float*)U, args.in[19] + (size_t)l * 3 * UPW, args.in[20] + (size_t)l * UPW, ACT);
        }
#endif
#if PH_MASK & 256
        else {
            row_phase(gw, NGW, lane, xres, TMP, args.in[17] + l * DM, l + 1 < DEPTH ? args.in[14] + (l + 1) * DM : nullptr, xres, l + 1 < DEPTH ? XN : nullptr);
        }
#endif
      }
    }
}

#undef tabg
#undef Win_t
#undef Wo3_t
#undef Wout_t
#undef Wup_t
#undef Wdn_t
#undef XN
#undef P
#undef Y
#undef TMP
#undef MIX
#undef U
#undef ACT
extern "C" void kernel_launch(void* const* d_in, const int* in_sizes, int n_in, void* d_out, int out_size, void* d_ws, size_t ws_size, hipStream_t stream) {
    static int grid = 0;
    if (grid == 0) {
        if (n_in != 22 || out_size != M * DM || ws_size < WS_END) { fprintf(stderr, "kernel_launch: unexpected problem (n_in %d out %d ws %zu)\n", n_in, out_size, ws_size); grid = -1; return; }
        int dev = 0, cus = 0, per_cu = 0;
        hipGetDevice(&dev); hipDeviceGetAttribute(&cus, hipDeviceAttributeMultiprocessorCount, dev);
        hipFuncSetAttribute((const void*)fwd_kernel, hipFuncAttributeMaxDynamicSharedMemorySize, LDS_BYTES);
        hipOccupancyMaxActiveBlocksPerMultiprocessor(&per_cu, (const void*)fwd_kernel, 512, LDS_BYTES);
        (void)hipGetLastError();
        if (per_cu < 1) { fprintf(stderr, "kernel_launch: occupancy query says %d blocks per CU\n", per_cu); per_cu = 1; }
        grid = cus;
        fprintf(stderr, "kernel_launch: grid %d (per_cu %d)\n", grid, per_cu);
    }
    if (grid < 0) return;
    hipMemsetAsync((char*)d_ws + WS_CTL, 0, CTL_ZERO_BYTES, stream);
    Args a{};
    for (int i = 0; i < 22; ++i) a.in[i] = (const float*)d_in[i];
    a.out = (float*)d_out; a.ws = (unsigned char*)d_ws;
#if N_LAUNCH_MODE == 1
    a.ph_lo = 0; a.ph_hi = N_PHASES;
    void* kargs[] = {&a};
    hipError_t e = hipLaunchCooperativeKernel((const void*)fwd_kernel, dim3(grid), dim3(512), kargs, LDS_BYTES, stream);
    if (e != hipSuccess) fprintf(stderr, "cooperative launch failed: %s (grid %d)\n", hipGetErrorString(e), grid);
#else
    for (int ph = 0; ph < N_PHASES; ++ph) { a.ph_lo = ph; a.ph_hi = ph + 1; hipLaunchKernelGGL(fwd_kernel, dim3(grid), dim3(512), LDS_BYTES, stream, a); }
#endif
}
```
